# Optimizing an MI355X kernel written in HIP

```python
import math
import jax, jax.numpy as jnp
from jax import lax
import numpy as np

D_MODEL = 1024
BATCH = 8
SEQ = 4096
DEPTH = 1

HEAD_DIM = 64
D_MIX = D_MODEL
D_MIX_A = D_MIX // 2
D_MIX_B = D_MIX - D_MIX_A
N_HEADS_A = D_MIX_A // HEAD_DIM
DIFF_QK_DIM = HEAD_DIM // 2
N_HEADS_B = D_MIX_B // HEAD_DIM
GQA_GROUP = 4
N_KV_B = N_HEADS_B // GQA_GROUP
D_FF = ((8 * D_MODEL // 3 + 127) // 128) * 128
GRID_W = 64
ROPE_THETA = 10000.0
ROPE_AXIS_DIM = HEAD_DIM // 2
N_BUCKETS = 32
MAX_DISTANCE = 128
Q_BLOCK = 128
EPS = 1e-6
COLS_QA = N_HEADS_A * 2 * DIFF_QK_DIM
COLS_KA = N_HEADS_A * 2 * DIFF_QK_DIM
COLS_VA = N_HEADS_A * HEAD_DIM
COLS_QB = N_HEADS_B * HEAD_DIM
COLS_KB = N_KV_B * HEAD_DIM
COLS_VB = N_KV_B * HEAD_DIM
D_IN_PROJ = COLS_QA + COLS_KA + COLS_VA + COLS_QB + COLS_KB + COLS_VB

kernel_name = "hybrid_diffattn_gqa_axialrope_macaron"


def rms_norm(x, g):
    xf = x.astype(jnp.float32)
    y = xf * lax.rsqrt(jnp.mean(xf * xf, axis=-1, keepdims=True) + EPS)
    return (y * g.astype(jnp.float32)).astype(x.dtype)


def swiglu(x, w_gate, w_up, w_down):
    return (jax.nn.silu(x @ w_gate) * (x @ w_up)) @ w_down


def t5_bucket(rel):
    nb = N_BUCKETS // 2
    max_exact = nb // 2
    ret = jnp.where(rel > 0, nb, 0)
    n = jnp.abs(rel)
    nf = jnp.maximum(n, 1).astype(jnp.float32)
    large = max_exact + (jnp.log(nf / max_exact) / math.log(MAX_DISTANCE / max_exact)
                         * (nb - max_exact)).astype(jnp.int32)
    large = jnp.minimum(large, nb - 1)
    return ret + jnp.where(n < max_exact, n, large)


def axial_rope_tables(S):
    rows = S // GRID_W
    row = jnp.repeat(jnp.arange(rows, dtype=jnp.int32), GRID_W).astype(jnp.float32)
    col = jnp.tile(jnp.arange(GRID_W, dtype=jnp.int32), rows).astype(jnp.float32)
    inv = ROPE_THETA ** (-jnp.arange(0, ROPE_AXIS_DIM, 2, dtype=jnp.float32) / ROPE_AXIS_DIM)
    ang = jnp.concatenate([row[:, None] * inv[None], col[:, None] * inv[None]], axis=-1)
    return jnp.cos(ang), jnp.sin(ang)


def apply_rope(x, cos, sin):
    xf = x.astype(jnp.float32).reshape(x.shape[:-1] + (HEAD_DIM // 2, 2))
    x0, x1 = xf[..., 0], xf[..., 1]
    out = jnp.stack([x0 * cos - x1 * sin, x0 * sin + x1 * cos], axis=-1)
    return out.reshape(x.shape).astype(x.dtype)


def split_blocks(t):
    B, H, S, d = t.shape
    return t.reshape(B, H, S // Q_BLOCK, Q_BLOCK, d).transpose(2, 0, 1, 3, 4)


def merge_blocks(t):
    nblk, B, H, qb, d = t.shape
    return t.transpose(1, 2, 0, 3, 4).reshape(B, H, nblk * qb, d)


def diff_attention(q1, q2, k1, k2, v, lam, rel_bias):
    S = q1.shape[2]
    nblk = S // Q_BLOCK
    scale = DIFF_QK_DIM ** -0.5
    kpos = jnp.arange(S, dtype=jnp.int32)
    table = rel_bias.astype(jnp.float32)

    def block(args):
        i, a1, a2 = args
        qpos = i * Q_BLOCK + jnp.arange(Q_BLOCK, dtype=jnp.int32)
        bias = table[t5_bucket(kpos[None, :] - qpos[:, None])]
        bias = bias.transpose(2, 0, 1)[None]
        s1 = jnp.einsum('bhqd,bhkd->bhqk', a1, k1, preferred_element_type=jnp.float32) * scale + bias
        s2 = jnp.einsum('bhqd,bhkd->bhqk', a2, k2, preferred_element_type=jnp.float32) * scale + bias
        p = jax.nn.softmax(s1, axis=-1) - lam * jax.nn.softmax(s2, axis=-1)
        return jnp.einsum('bhqk,bhkd->bhqd', p.astype(v.dtype), v)

    out = lax.map(block, (jnp.arange(nblk, dtype=jnp.int32), split_blocks(q1), split_blocks(q2)))
    return merge_blocks(out)


def gqa_attention(q, k, v):
    B, HB, S, d = q.shape
    scale = d ** -0.5

    def block(qb):
        qg = qb.reshape(B, N_KV_B, GQA_GROUP, Q_BLOCK, d)
        s = jnp.einsum('bkgqd,bksd->bkgqs', qg, k, preferred_element_type=jnp.float32) * scale
        p = jax.nn.softmax(s, axis=-1)
        o = jnp.einsum('bkgqs,bksd->bkgqd', p.astype(v.dtype), v)
        return o.reshape(B, HB, Q_BLOCK, d)

    return merge_blocks(lax.map(block, split_blocks(q)))


def setup_inputs(seed: int = 0) -> dict:
    key = jax.random.key(seed)
    ks = jax.random.split(key, 24)
    f32 = jnp.float32

    def w(k, shape, fan_in):
        return jax.random.normal(k, shape, f32) * fan_in ** -0.5

    def gain(k, shape):
        return 1.0 + 0.01 * jax.random.normal(k, shape, f32)

    L = DEPTH
    return {
        "x": jax.random.normal(ks[0], (BATCH, SEQ, D_MODEL), f32),
        "ffn1_norm": gain(ks[1], (L, D_MODEL)),
        "ffn1_w_gate": w(ks[2], (L, D_MODEL, D_FF), D_MODEL),
        "ffn1_w_up": w(ks[3], (L, D_MODEL, D_FF), D_MODEL),
        "ffn1_w_down": w(ks[4], (L, D_FF, D_MODEL), D_FF),
        "mix_norm": gain(ks[5], (L, D_MODEL)),
        "w_in": w(ks[6], (L, D_MODEL, D_IN_PROJ), D_MODEL),
        "lambda_q1": 0.1 * jax.random.normal(ks[7], (L, DIFF_QK_DIM), f32),
        "lambda_k1": 0.1 * jax.random.normal(ks[8], (L, DIFF_QK_DIM), f32),
        "lambda_q2": 0.1 * jax.random.normal(ks[9], (L, DIFF_QK_DIM), f32),
        "lambda_k2": 0.1 * jax.random.normal(ks[10], (L, DIFF_QK_DIM), f32),
        "diff_subln": gain(ks[11], (L, HEAD_DIM)),
        "q_norm": gain(ks[12], (L, HEAD_DIM)),
        "k_norm": gain(ks[13], (L, HEAD_DIM)),
        "rel_bias": 0.5 * jax.random.normal(ks[14], (N_BUCKETS, N_HEADS_A), f32),
        "w_out": w(ks[15], (L, D_MIX, D_MODEL), D_MIX),
        "ffn2_norm": gain(ks[16], (L, D_MODEL)),
        "ffn2_w_gate": w(ks[17], (L, D_MODEL, D_FF), D_MODEL),
        "ffn2_w_up": w(ks[18], (L, D_MODEL, D_FF), D_MODEL),
        "ffn2_w_down": w(ks[19], (L, D_FF, D_MODEL), D_FF),
        "final_norm": gain(ks[20], (D_MODEL,)),
    }


def reference(x, ffn1_norm, ffn1_w_gate, ffn1_w_up, ffn1_w_down, mix_norm, w_in,
              lambda_q1, lambda_k1, lambda_q2, lambda_k2, diff_subln, q_norm, k_norm,
              rel_bias, w_out, ffn2_norm, ffn2_w_gate, ffn2_w_up, ffn2_w_down, final_norm):
    B, S, _ = x.shape
    cos, sin = axial_rope_tables(S)
    offs = np.cumsum([0, COLS_QA, COLS_KA, COLS_VA, COLS_QB, COLS_KB, COLS_VB])

    for l in range(DEPTH):
        lambda_init = 0.8 - 0.6 * math.exp(-0.3 * l)

        x = x + 0.5 * swiglu(rms_norm(x, ffn1_norm[l]), ffn1_w_gate[l], ffn1_w_up[l], ffn1_w_down[l])

        h = rms_norm(x, mix_norm[l])
        proj = h @ w_in[l]
        qa, ka, va, qb, kb, vb = [proj[..., offs[i]:offs[i + 1]] for i in range(6)]

        qa = qa.reshape(B, S, N_HEADS_A, 2, DIFF_QK_DIM).transpose(0, 2, 3, 1, 4)
        ka = ka.reshape(B, S, N_HEADS_A, 2, DIFF_QK_DIM).transpose(0, 2, 3, 1, 4)
        va = va.reshape(B, S, N_HEADS_A, HEAD_DIM).transpose(0, 2, 1, 3)
        lam = (jnp.exp(jnp.sum(lambda_q1[l].astype(jnp.float32) * lambda_k1[l].astype(jnp.float32)))
               - jnp.exp(jnp.sum(lambda_q2[l].astype(jnp.float32) * lambda_k2[l].astype(jnp.float32)))
               + lambda_init)
        oa = diff_attention(qa[:, :, 0], qa[:, :, 1], ka[:, :, 0], ka[:, :, 1], va, lam, rel_bias)
        oa = rms_norm(oa, diff_subln[l]) * (1.0 - lambda_init)
        oa = oa.transpose(0, 2, 1, 3).reshape(B, S, D_MIX_A)

        qb = rms_norm(qb.reshape(B, S, N_HEADS_B, HEAD_DIM), q_norm[l]).transpose(0, 2, 1, 3)
        kb = rms_norm(kb.reshape(B, S, N_KV_B, HEAD_DIM), k_norm[l]).transpose(0, 2, 1, 3)
        vb = vb.reshape(B, S, N_KV_B, HEAD_DIM).transpose(0, 2, 1, 3)
        qb = apply_rope(qb, cos, sin)
        kb = apply_rope(kb, cos, sin)
        ob = gqa_attention(qb, kb, vb).transpose(0, 2, 1, 3).reshape(B, S, D_MIX_B)

        x = x + jnp.concatenate([oa, ob], axis=-1) @ w_out[l]

        x = x + 0.5 * swiglu(rms_norm(x, ffn2_norm[l]), ffn2_w_gate[l], ffn2_w_up[l], ffn2_w_down[l])

    return rms_norm(x, final_norm)
```

```cpp
#include <hip/hip_runtime.h>
#include <cstdio>
#include <cstdint>
#include <cmath>

constexpr int D_MODEL = 1024, BATCH = 8, SEQ = 4096, D_FF = 2816, D_IN = 2304;
constexpr int MC = SEQ;
constexpr float EPS = 1e-6f;

__device__ __forceinline__ float wave_sum(float v) {
#pragma unroll
    for (int o = 1; o < 64; o <<= 1) v += __shfl_xor(v, o);
    return v;
}
__device__ __forceinline__ float wave_max(float v) {
#pragma unroll
    for (int o = 1; o < 64; o <<= 1) v = fmaxf(v, __shfl_xor(v, o));
    return v;
}

__global__ void __launch_bounds__(256) rmsnorm_k(const float* __restrict__ x, const float* __restrict__ g, float* __restrict__ y, int rows) {
    const int row = blockIdx.x * 4 + (threadIdx.x >> 6), lane = threadIdx.x & 63;
    if (row >= rows) return;
    const float4* xr = (const float4*)(x + (size_t)row * D_MODEL);
    float4 v[4]; float s = 0.f;
#pragma unroll
    for (int j = 0; j < 4; ++j) { v[j] = xr[lane + 64 * j]; s += v[j].x * v[j].x + v[j].y * v[j].y + v[j].z * v[j].z + v[j].w * v[j].w; }
    s = wave_sum(s);
    const float r = rsqrtf(s * (1.f / D_MODEL) + EPS);
    float4* yr = (float4*)(y + (size_t)row * D_MODEL);
    const float4* gr = (const float4*)g;
#pragma unroll
    for (int j = 0; j < 4; ++j) { const float4 gg = gr[lane + 64 * j]; float4 o; o.x = v[j].x * r * gg.x; o.y = v[j].y * r * gg.y; o.z = v[j].z * r * gg.z; o.w = v[j].w * r * gg.w; yr[lane + 64 * j] = o; }
}

__global__ void __launch_bounds__(256) gemm_k(const float* __restrict__ A, int lda, const float* __restrict__ B, int ldb, float* __restrict__ C, int ldc, int K,
                                              const float* __restrict__ R, float alpha) {
    __shared__ float As[16][64 + 4];
    __shared__ float Bs[16][64 + 4];
    const int tid = threadIdx.x, tx = tid & 15, ty = tid >> 4;
    const int m0 = blockIdx.y * 64, n0 = blockIdx.x * 64;
    float acc[4][4] = {};
    for (int k0 = 0; k0 < K; k0 += 16) {
        {
            const int r = tid >> 2, c = (tid & 3) * 4;
            const float4 a = *(const float4*)(A + (size_t)(m0 + r) * lda + k0 + c);
            As[c + 0][r] = a.x; As[c + 1][r] = a.y; As[c + 2][r] = a.z; As[c + 3][r] = a.w;
        }
        {
            const int r = tid >> 4, c = (tid & 15) * 4;
            const float4 b = *(const float4*)(B + (size_t)(k0 + r) * ldb + n0 + c);
            *(float4*)&Bs[r][c] = b;
        }
        __syncthreads();
#pragma unroll
        for (int kk = 0; kk < 16; ++kk) {
            const float4 a = *(const float4*)&As[kk][ty * 4];
            const float4 b = *(const float4*)&Bs[kk][tx * 4];
            const float av[4] = {a.x, a.y, a.z, a.w}, bv[4] = {b.x, b.y, b.z, b.w};
#pragma unroll
            for (int i = 0; i < 4; ++i)
#pragma unroll
                for (int j = 0; j < 4; ++j) acc[i][j] = fmaf(av[i], bv[j], acc[i][j]);
        }
        __syncthreads();
    }
#pragma unroll
    for (int i = 0; i < 4; ++i) {
        const size_t off = (size_t)(m0 + ty * 4 + i) * ldc + n0 + tx * 4;
        float4 o = make_float4(acc[i][0], acc[i][1], acc[i][2], acc[i][3]);
        if (R) { const float4 r = *(const float4*)(R + off); o.x = r.x + alpha * o.x; o.y = r.y + alpha * o.y; o.z = r.z + alpha * o.z; o.w = r.w + alpha * o.w; }
        *(float4*)(C + off) = o;
    }
}

__global__ void swiglu_k(float* __restrict__ G, const float* __restrict__ U, size_t n) {
    const size_t i = (size_t)blockIdx.x * blockDim.x + threadIdx.x;
    if (i < n) { const float g = G[i]; G[i] = g / (1.f + expf(-g)) * U[i]; }
}

__global__ void setup_k(const float* lq1, const float* lk1, const float* lq2, const float* lk2, const float* rel_bias, float* misc, float* bias_rel) {
    const int i = blockIdx.x * blockDim.x + threadIdx.x;
    if (i == 0) {
        float s1 = 0.f, s2 = 0.f;
        for (int d = 0; d < 32; ++d) { s1 += lq1[d] * lk1[d]; s2 += lq2[d] * lk2[d]; }
        misc[0] = expf(s1) - expf(s2) + 0.2f;
    }
    if (i < 8191) {
        const int rel = i - 4095; const int n = rel < 0 ? -rel : rel;
        int bkt;
        if (n < 8) bkt = n; else { int l = 2 + (31 - __clz(n * n)); bkt = l < 15 ? l : 15; }
        if (rel > 0) bkt += 16;
        for (int h = 0; h < 8; ++h) bias_rel[h * 8192 + i] = rel_bias[bkt * 8 + h];
    }
}

__global__ void __launch_bounds__(256) qknorm_rope_k(float* __restrict__ proj, const float* __restrict__ qn, const float* __restrict__ kn) {
    const int w = blockIdx.x * 4 + (threadIdx.x >> 6), lane = threadIdx.x & 63;
    const int s = w / 10, slot = w % 10;
    if (s >= MC) return;
    float* p = proj + (size_t)s * D_IN + 1536 + slot * 64;
    const float x = p[lane];
    const float ss = wave_sum(x * x);
    const float g = slot < 8 ? qn[lane] : kn[lane];
    const float y = x * rsqrtf(ss * (1.f / 64.f) + EPS) * g;
    const int i = lane >> 1;
    const float pos = (i < 16) ? (float)(s >> 6) : (float)(s & 63);
    const float inv = powf(10000.f, -(float)(i & 15) / 16.f);
    const float ang = pos * inv;
    const float c = cosf(ang), sn = sinf(ang);
    const float other = __shfl_xor(y, 1);
    const float o = (lane & 1) ? (other * sn + y * c) : (y * c - other * sn);
    p[lane] = o;
}

template <int DQK, bool BIAS>
__global__ void __launch_bounds__(256) attn_k(const float* __restrict__ proj, float* __restrict__ out, int out_ld, int nvh,
                                              int qbase, int qstride, int kbase, int kstride, int kdiv, int vbase, int vdiv, float scale, const float* __restrict__ bias_rel) {
    __shared__ float P[4][SEQ];
    const int wv = threadIdx.x >> 6, lane = threadIdx.x & 63;
    const int w = blockIdx.x * 4 + wv;
    const int s = w / nvh, vh = w % nvh;
    float q[DQK];
    const float* qp = proj + (size_t)s * D_IN + qbase + vh * qstride;
#pragma unroll
    for (int d = 0; d < DQK; ++d) q[d] = qp[d];
    const float* kp = proj + kbase + (vh / kdiv) * kstride;
    const float* br = BIAS ? bias_rel + (vh >> 1) * 8192 + 4095 - s : nullptr;
    float mx = -INFINITY;
    for (int j = 0; j < SEQ / 64; ++j) {
        const int k = j * 64 + lane;
        const float4* kr = (const float4*)(kp + (size_t)k * D_IN);
        float acc = 0.f;
#pragma unroll
        for (int d4 = 0; d4 < DQK / 4; ++d4) { const float4 kk = kr[d4]; acc += q[4 * d4] * kk.x + q[4 * d4 + 1] * kk.y + q[4 * d4 + 2] * kk.z + q[4 * d4 + 3] * kk.w; }
        acc *= scale;
        if (BIAS) acc += br[k];
        P[wv][k] = acc; mx = fmaxf(mx, acc);
    }
    mx = wave_max(mx);
    float l = 0.f;
    for (int j = 0; j < SEQ / 64; ++j) { const int k = j * 64 + lane; const float e = expf(P[wv][k] - mx); P[wv][k] = e; l += e; }
    l = wave_sum(l);
    __syncthreads();
    const float* vp = proj + vbase + (vh / vdiv) * 64 + lane;
    float o = 0.f;
    for (int k = 0; k < SEQ; ++k) o = fmaf(P[wv][k], vp[(size_t)k * D_IN], o);
    out[(size_t)s * out_ld + vh * 64 + lane] = o / l;
}

__global__ void __launch_bounds__(256) diff_combine_k(const float* __restrict__ tmp, const float* __restrict__ misc, const float* __restrict__ subln, float* __restrict__ ao) {
    const int w = blockIdx.x * 4 + (threadIdx.x >> 6), lane = threadIdx.x & 63;
    const int s = w >> 3, h = w & 7;
    const float lam = misc[0];
    const float v = tmp[(size_t)s * 1024 + (2 * h) * 64 + lane] - lam * tmp[(size_t)s * 1024 + (2 * h + 1) * 64 + lane];
    const float ss = wave_sum(v * v);
    ao[(size_t)s * 1024 + h * 64 + lane] = v * rsqrtf(ss * (1.f / 64.f) + EPS) * subln[lane] * 0.8f;
}

extern "C" void kernel_launch(void* const* d_in, const int* in_sizes, int n_in, void* d_out, int out_size, void* d_ws, size_t ws_size, hipStream_t stream) {
    const float* x = (const float*)d_in[0];
    const float* g1 = (const float*)d_in[1]; const float* wg1 = (const float*)d_in[2]; const float* wu1 = (const float*)d_in[3]; const float* wd1 = (const float*)d_in[4];
    const float* gm = (const float*)d_in[5]; const float* w_in = (const float*)d_in[6];
    const float* lq1 = (const float*)d_in[7]; const float* lk1 = (const float*)d_in[8]; const float* lq2 = (const float*)d_in[9]; const float* lk2 = (const float*)d_in[10];
    const float* subln = (const float*)d_in[11]; const float* qn = (const float*)d_in[12]; const float* kn = (const float*)d_in[13]; const float* rel_bias = (const float*)d_in[14];
    const float* w_out = (const float*)d_in[15];
    const float* g2 = (const float*)d_in[16]; const float* wg2 = (const float*)d_in[17]; const float* wu2 = (const float*)d_in[18]; const float* wd2 = (const float*)d_in[19];
    const float* gf = (const float*)d_in[20];
    float* out = (float*)d_out;
    float* ws = (float*)d_ws;
    size_t o = 0;
    float* misc = ws + o; o += 64;
    float* bias_rel = ws + o; o += 8 * 8192;
    float* H = ws + o; o += (size_t)MC * D_MODEL;
    float* G = ws + o; o += (size_t)MC * D_FF;
    float* U = ws + o; o += (size_t)MC * D_FF;
    float* X1 = ws + o; o += (size_t)MC * D_MODEL;
    float* PR = ws + o; o += (size_t)MC * D_IN;
    float* TMP = ws + o; o += (size_t)MC * 1024;
    float* AO = ws + o; o += (size_t)MC * 1024;
    float* X2 = ws + o; o += (size_t)MC * D_MODEL;
    float* X3 = ws + o; o += (size_t)MC * D_MODEL;
    if (o * 4 > ws_size) { fprintf(stderr, "ws too small\n"); return; }
    setup_k<<<32, 256, 0, stream>>>(lq1, lk1, lq2, lk2, rel_bias, misc, bias_rel);
    for (int b = 0; b < BATCH; ++b) {
        const float* xb = x + (size_t)b * MC * D_MODEL;
        float* ob = out + (size_t)b * MC * D_MODEL;
        rmsnorm_k<<<MC / 4, 256, 0, stream>>>(xb, g1, H, MC);
        gemm_k<<<dim3(D_FF / 64, MC / 64), 256, 0, stream>>>(H, D_MODEL, wg1, D_FF, G, D_FF, D_MODEL, nullptr, 0.f);
        gemm_k<<<dim3(D_FF / 64, MC / 64), 256, 0, stream>>>(H, D_MODEL, wu1, D_FF, U, D_FF, D_MODEL, nullptr, 0.f);
        swiglu_k<<<(unsigned)(((size_t)MC * D_FF + 255) / 256), 256, 0, stream>>>(G, U, (size_t)MC * D_FF);
        gemm_k<<<dim3(D_MODEL / 64, MC / 64), 256, 0, stream>>>(G, D_FF, wd1, D_MODEL, X1, D_MODEL, D_FF, xb, 0.5f);
        rmsnorm_k<<<MC / 4, 256, 0, stream>>>(X1, gm, H, MC);
        gemm_k<<<dim3(D_IN / 64, MC / 64), 256, 0, stream>>>(H, D_MODEL, w_in, D_IN, PR, D_IN, D_MODEL, nullptr, 0.f);
        qknorm_rope_k<<<MC * 10 / 4, 256, 0, stream>>>(PR, qn, kn);
        attn_k<32, true><<<MC * 16 / 4, 256, 0, stream>>>(PR, TMP, 1024, 16, 0, 32, 512, 32, 1, 1024, 2, 0.17677669529663687f, bias_rel);
        diff_combine_k<<<MC * 8 / 4, 256, 0, stream>>>(TMP, misc, subln, AO);
        attn_k<64, false><<<MC * 8 / 4, 256, 0, stream>>>(PR, AO + 512, 1024, 8, 1536, 64, 2048, 64, 4, 2176, 4, 0.125f, nullptr);
        gemm_k<<<dim3(D_MODEL / 64, MC / 64), 256, 0, stream>>>(AO, 1024, w_out, D_MODEL, X2, D_MODEL, 1024, X1, 1.0f);
        rmsnorm_k<<<MC / 4, 256, 0, stream>>>(X2, g2, H, MC);
        gemm_k<<<dim3(D_FF / 64, MC / 64), 256, 0, stream>>>(H, D_MODEL, wg2, D_FF, G, D_FF, D_MODEL, nullptr, 0.f);
        gemm_k<<<dim3(D_FF / 64, MC / 64), 256, 0, stream>>>(H, D_MODEL, wu2, D_FF, U, D_FF, D_MODEL, nullptr, 0.f);
        swiglu_k<<<(unsigned)(((size_t)MC * D_FF + 255) / 256), 256, 0, stream>>>(G, U, (size_t)MC * D_FF);
        gemm_k<<<dim3(D_MODEL / 64, MC / 64), 256, 0, stream>>>(G, D_FF, wd2, D_MODEL, X3, D_MODEL, D_FF, X2, 0.5f);
        rmsnorm_k<<<MC / 4, 256, 0, stream>>>(X3, gf, ob, MC);
    }
}
```

```cpp
#include <hip/hip_runtime.h>
#include <cstdio>
#include <cstdint>
#include <cmath>
namespace pg8 {
#define PG8_LAS __attribute__((address_space(3)))
typedef unsigned short bf16_t;
typedef short bf16x8 __attribute__((ext_vector_type(8)));
typedef float f32x4 __attribute__((ext_vector_type(4)));
typedef unsigned u32x4 __attribute__((ext_vector_type(4)));
constexpr int BM = 256, BK = 64, HALF = 128, HTB = HALF * BK * 2  , STAGE_BYTES = 8 * HTB, NXCD = 8, WGM = 8;

__host__ __device__ __forceinline__ int lds_byte(int r, int c) { const int st = (r >> 4) * 2 + (c >> 5), rr = r & 15, cc = c & 31, ob = rr * 64 + cc * 2; return st * 1024 + (ob ^ (((ob >> 9) & 1) << 5)); }
__host__ __device__ __forceinline__ void stage_rc(int b, int& R, int& C) { const int st = b / 1024, sb = b % 1024, swz = sb ^ (((sb >> 9) & 1) << 5); R = (st >> 1) * 16 + swz / 64; C = (st & 1) * 32 + (swz % 64) / 2; }
__host__ __device__ __forceinline__ int perm32(int rho) { const int n = rho >> 4, i = rho & 15; return 8 * (i >> 2) + 4 * n + (i & 3); }

struct Unit { int pm, pn; };
struct Gemm { const bf16_t* A; const bf16_t* Bt; int M, N, K; };

struct StaticOrder {
    int nM, nN, nwg, G, c;
    __host__ __device__ void init(int M, int N, int G_, int c_) { nM = M / BM; nN = N / BM; nwg = nM * nN; G = G_; c = c_; }
    __host__ __device__ bool next(int i, Unit& u) const {
        const long L = (long)i * G + c; if (L >= nwg) return false;
        int wgid = (int)L; { const int q = nwg / NXCD, r = nwg % NXCD, xcd = wgid % NXCD, off = wgid / NXCD; wgid = (xcd < r ? xcd * (q + 1) : r * (q + 1) + (xcd - r) * q) + off; }
        const int nig = WGM * nN, gid = wgid / nig, fm = gid * WGM, gsz = (nM - fm) < WGM ? (nM - fm) : WGM;
        u.pm = fm + ((wgid % nig) % gsz); u.pn = (wgid % nig) / gsz; return true;
    }
    __device__ __forceinline__ void a_ready(const Unit&) const {}
    __device__ __forceinline__ void done(const Unit&) const {}
};

__device__ __forceinline__ unsigned cvt_pk_bf16(float lo, float hi) { unsigned r; asm volatile("v_cvt_pk_bf16_f32 %0, %1, %2" : "=v"(r) : "v"(lo), "v"(hi)); return r; }
constexpr float RMS_EPS = 1e-6f;
__device__ __forceinline__ float rstd_from_parts(const float* ss, int row) {
    const f32x4* p = (const f32x4*)(ss + (size_t)row * 16);
    const f32x4 a = p[0], b = p[1], c = p[2], d = p[3];
    const float s = (((a[0] + a[1]) + (a[2] + a[3])) + ((b[0] + b[1]) + (b[2] + b[3]))) + (((c[0] + c[1]) + (c[2] + c[3])) + ((d[0] + d[1]) + (d[2] + d[3])));
    return rsqrtf(s * (1.0f / 1024.0f) + RMS_EPS);
}
__device__ __forceinline__ float silu_mul(float g, float u) { return g * __builtin_amdgcn_rcpf(1.0f + __builtin_amdgcn_exp2f(-1.4426950408889634f * g)) * u; }

template <bool RS> struct EpiSwiGLU {
    static constexpr bool PERM = true, AFTER_DRAIN = false;
    bf16_t* O; int ldo; const float* ss;
    __device__ __forceinline__ void operator()(const f32x4 (&acc)[2][2][4][2], const Unit& u, int wr, int wc, int fr, int fq) const {
        const int row0 = u.pm * BM + wr * 64 + fr, col0 = u.pn * HALF + wc * 32 + 8 * fq;
#pragma unroll
        for (int ai = 0; ai < 2; ++ai)
#pragma unroll
            for (int m = 0; m < 4; ++m) {
                const int row = row0 + ai * HALF + m * 16;
                const float rs = RS ? rstd_from_parts(ss, row) : 1.0f;
                const f32x4 g0 = acc[ai][0][m][0] * rs, g1 = acc[ai][0][m][1] * rs, u0 = acc[ai][1][m][0] * rs, u1 = acc[ai][1][m][1] * rs;
                u32x4 w;
                w.x = cvt_pk_bf16(silu_mul(g0[0], u0[0]), silu_mul(g0[1], u0[1])); w.y = cvt_pk_bf16(silu_mul(g0[2], u0[2]), silu_mul(g0[3], u0[3]));
                w.z = cvt_pk_bf16(silu_mul(g1[0], u1[0]), silu_mul(g1[1], u1[1])); w.w = cvt_pk_bf16(silu_mul(g1[2], u1[2]), silu_mul(g1[3], u1[3]));
                *(u32x4*)(O + (size_t)row * ldo + col0) = w;
            }
    }
};

template <bool WB> struct EpiResid {
    static constexpr bool PERM = true, AFTER_DRAIN = false;
    const float* R; float* Xf; bf16_t* Xb; float* ss; float alpha;
    __device__ __forceinline__ void operator()(const f32x4 (&acc)[2][2][4][2], const Unit& u, int wr, int wc, int fr, int fq) const {
        const int row0 = u.pm * BM + wr * 64 + fr, col0 = u.pn * BM + wc * 32 + 8 * fq;
#pragma unroll
        for (int ai = 0; ai < 2; ++ai)
#pragma unroll
            for (int m = 0; m < 4; ++m) {
                const int row = row0 + ai * HALF + m * 16; const size_t off = (size_t)row * 1024 + col0; float q = 0.f;
#pragma unroll
                for (int bj = 0; bj < 2; ++bj) {
                    const f32x4 r0 = *(const f32x4*)(R + off + bj * HALF), r1 = *(const f32x4*)(R + off + bj * HALF + 4);
                    const f32x4 v0 = r0 + acc[ai][bj][m][0] * alpha, v1 = r1 + acc[ai][bj][m][1] * alpha;
                    *(f32x4*)(Xf + off + bj * HALF) = v0; *(f32x4*)(Xf + off + bj * HALF + 4) = v1;
                    if (WB) { u32x4 w; w.x = cvt_pk_bf16(v0[0], v0[1]); w.y = cvt_pk_bf16(v0[2], v0[3]); w.z = cvt_pk_bf16(v1[0], v1[1]); w.w = cvt_pk_bf16(v1[2], v1[3]);
                        *(u32x4*)(Xb + off + bj * HALF) = w;
                        q += ((v0[0] * v0[0] + v0[1] * v0[1]) + (v0[2] * v0[2] + v0[3] * v0[3])) + ((v1[0] * v1[0] + v1[1] * v1[1]) + (v1[2] * v1[2] + v1[3] * v1[3])); }
                }
                if (WB) { q += __shfl_xor(q, 16); q += __shfl_xor(q, 32); if (fq == 0) ss[(size_t)row * 16 + u.pn * 4 + wc] = q; }
                asm volatile("" ::: "memory");
            }
    }
};

constexpr float C2A = 0.17677669529663687f * 1.4426950408889634f;
constexpr float C2B = 0.125f * 1.4426950408889634f;
struct EpiProj {
    static constexpr bool PERM = true, AFTER_DRAIN = false;
    bf16_t* O; const float* ss; const float* qn; const float* kn; const float* cs;
    __device__ __forceinline__ void operator()(const f32x4 (&acc)[2][2][4][2], const Unit& u, int wr, int wc, int fr, int fq) const {
        const int pn = u.pn, row0 = u.pm * BM + wr * 64 + fr, colbase = pn * 256 + wc * 64 + 8 * fq;
        int mode = 0; float qscale = 1.0f; const float* gain = qn;
        if (pn < 2) { mode = 1; qscale = C2A; } else if (pn < 6) { mode = 0; } else if (pn < 8) { mode = 2; qscale = C2B; } else if (wc < 2) { mode = 2; gain = kn; }
        f32x4 gv[2][2];
#pragma unroll
        for (int bj = 0; bj < 2; ++bj)
#pragma unroll
            for (int n = 0; n < 2; ++n) gv[bj][n] = (mode == 2) ? *(const f32x4*)(gain + 32 * bj + 8 * fq + 4 * n) : (f32x4){1.f, 1.f, 1.f, 1.f};
#pragma unroll
        for (int ai = 0; ai < 2; ++ai)
#pragma unroll
            for (int m = 0; m < 4; ++m) {
                const int row = row0 + ai * HALF + m * 16;
                const float rs = rstd_from_parts(ss, row);
                f32x4 v[2][2];
#pragma unroll
                for (int bj = 0; bj < 2; ++bj)
#pragma unroll
                    for (int n = 0; n < 2; ++n) v[bj][n] = acc[ai][bj][m][n] * rs;
                if (mode == 2) {
                    float q = 0.f;
#pragma unroll
                    for (int bj = 0; bj < 2; ++bj)
#pragma unroll
                        for (int n = 0; n < 2; ++n) q += (v[bj][n][0] * v[bj][n][0] + v[bj][n][1] * v[bj][n][1]) + (v[bj][n][2] * v[bj][n][2] + v[bj][n][3] * v[bj][n][3]);
                    q += __shfl_xor(q, 16); q += __shfl_xor(q, 32);
                    const float hr = rsqrtf(q * (1.0f / 64.0f) + RMS_EPS);
                    const int s = row & 4095;
#pragma unroll
                    for (int bj = 0; bj < 2; ++bj) {
                        const int pos = bj ? (s & 63) : (s >> 6);
                        const f32x4* t = (const f32x4*)(cs + (size_t)(pos * 16 + 4 * fq) * 2);
#pragma unroll
                        for (int n = 0; n < 2; ++n) {
                            const f32x4 x = v[bj][n] * hr * gv[bj][n], c = t[n];
                            f32x4 y; y[0] = x[0] * c[0] - x[1] * c[1]; y[1] = x[0] * c[1] + x[1] * c[0]; y[2] = x[2] * c[2] - x[3] * c[3]; y[3] = x[2] * c[3] + x[3] * c[2];
                            v[bj][n] = y * qscale;
                        }
                    }
                } else if (mode == 1) {
#pragma unroll
                    for (int bj = 0; bj < 2; ++bj)
#pragma unroll
                        for (int n = 0; n < 2; ++n) v[bj][n] = v[bj][n] * qscale;
                }
#pragma unroll
                for (int bj = 0; bj < 2; ++bj) {
                    u32x4 w; w.x = cvt_pk_bf16(v[bj][0][0], v[bj][0][1]); w.y = cvt_pk_bf16(v[bj][0][2], v[bj][0][3]); w.z = cvt_pk_bf16(v[bj][1][0], v[bj][1][1]); w.w = cvt_pk_bf16(v[bj][1][2], v[bj][1][3]);
                    *(u32x4*)(O + (size_t)row * 2304 + colbase + 32 * bj) = w;
                }
                asm volatile("" ::: "memory");
            }
    }
};
template <class Epi, class Sched, bool ALIGN_EPI = false, bool SP2 = false>
__device__ __forceinline__ void gemm_phase(PG8_LAS unsigned char* lds, const Gemm g, const Sched& S, const Epi& E) {
    const int tid = threadIdx.x, wid = __builtin_amdgcn_readfirstlane(tid >> 6), lane = tid & 63, wr = wid >> 2, wc = wid & 3, fr = lane & 15, fq = lane >> 4;
    const int K = g.K, nt = K / BK;
    unsigned voffA[2], voffB[2];
#pragma unroll
    for (int i = 0; i < 2; ++i) { int R, C; stage_rc(tid * 16 + i * 8192, R, C); const int Rb = Epi::PERM ? ((R & ~31) + perm32(R & 31)) : R;
        voffA[i] = (unsigned)(R * K + C) * 2u; voffB[i] = (unsigned)(Rb * K + C) * 2u; }
    const size_t kstep = (size_t)(BK * 2);
    const size_t hstep = (size_t)HALF * K * 2;
    const size_t tstep = 2 * hstep;
    const unsigned ldsw = (unsigned)wid * 1024u;
    const int aoff = lds_byte(wr * 64 + fr, fq * 8), boff = lds_byte(wc * 32 + fr, fq * 8);
#define PG8_SA(b, h) (((b) * 2 + (h)) * HTB)
#define PG8_SB(b, h) ((4 + (b) * 2 + (h)) * HTB)
#define PG8_STAGE(bufoff, gbase, voff) do { _Pragma("unroll") for (int _i = 0; _i < 2; ++_i) \
        __builtin_amdgcn_global_load_lds((const unsigned*)((const char*)(gbase) + (voff)[_i]), (PG8_LAS unsigned*)(lds + (bufoff) + ldsw + _i * 8192), 16, 0, 0); } while (0)
#define PG8_LDA(dst, b, h) do { _Pragma("unroll") for (int m = 0; m < 4; ++m) _Pragma("unroll") for (int k = 0; k < 2; ++k) dst[m][k] = *(const PG8_LAS bf16x8*)(lds + PG8_SA(b, h) + aoff + m * 2048 + k * 1024); } while (0)
#define PG8_LDB(dst, b, h) do { _Pragma("unroll") for (int n = 0; n < 2; ++n) _Pragma("unroll") for (int k = 0; k < 2; ++k) dst[n][k] = *(const PG8_LAS bf16x8*)(lds + PG8_SB(b, h) + boff + n * 2048 + k * 1024); } while (0)
#define PG8_MMA(ai, bj, At, Bt) do { __builtin_amdgcn_s_setprio(1); _Pragma("unroll") for (int m = 0; m < 4; ++m) _Pragma("unroll") for (int n = 0; n < 2; ++n) _Pragma("unroll") for (int k = 0; k < 2; ++k) \
        acc[ai][bj][m][n] = __builtin_amdgcn_mfma_f32_16x16x32_bf16(Bt[n][k], At[m][k], acc[ai][bj][m][n], 0, 0, 0); __builtin_amdgcn_s_setprio(0); } while (0)
#define PG8_WAIT_V(n) asm volatile("s_waitcnt vmcnt(" #n ")" ::: "memory")
#define PG8_WAIT_L(n) asm volatile("s_waitcnt lgkmcnt(" #n ")" ::: "memory")
#define PG8_BAR __builtin_amdgcn_s_barrier()
#define PG8_SCHED __builtin_amdgcn_sched_barrier(0)
    Unit cur, nxt; int ui = 0;
    if (!S.next(0, cur)) return;
    f32x4 acc[2][2][4][2];
#pragma unroll
    for (int a = 0; a < 2; ++a)
#pragma unroll
        for (int b = 0; b < 2; ++b)
#pragma unroll
            for (int m = 0; m < 4; ++m)
#pragma unroll
                for (int n = 0; n < 2; ++n) acc[a][b][m][n] = (f32x4){0.f, 0.f, 0.f, 0.f};
    bf16x8 At[4][2], B0[2][2], B1[2][2];
    const char* cA = (const char*)g.A + (size_t)cur.pm * tstep; const char* cB = (const char*)g.Bt + (size_t)cur.pn * tstep;
    S.a_ready(cur);
    if constexpr (SP2) {
        PG8_STAGE(PG8_SB(0, 0), cB, voffB); PG8_STAGE(PG8_SB(0, 1), cB + hstep, voffB); PG8_STAGE(PG8_SA(0, 0), cA, voffA); PG8_STAGE(PG8_SA(0, 1), cA + hstep, voffA);
        if (wr == 1) PG8_BAR;
        PG8_WAIT_V(2); PG8_BAR;
        PG8_STAGE(PG8_SB(1, 0), cB + kstep, voffB); PG8_STAGE(PG8_SA(1, 0), cA + kstep, voffA); PG8_STAGE(PG8_SB(1, 1), cB + hstep + kstep, voffB);
        PG8_WAIT_V(6); PG8_BAR;
    } else {
        PG8_STAGE(PG8_SB(0, 0), cB, voffB); PG8_STAGE(PG8_SA(0, 0), cA, voffA); PG8_STAGE(PG8_SB(0, 1), cB + hstep, voffB); PG8_STAGE(PG8_SA(0, 1), cA + hstep, voffA);
        if (wr == 1) PG8_BAR;
        PG8_WAIT_V(4); PG8_BAR;
        PG8_STAGE(PG8_SB(1, 0), cB + kstep, voffB); PG8_STAGE(PG8_SA(1, 0), cA + kstep, voffA); PG8_STAGE(PG8_SB(1, 1), cB + hstep + kstep, voffB);
        PG8_WAIT_V(6); PG8_BAR;
    }
    for (;;) {
        const bool has_next = S.next(ui + 1, nxt);
        const char* nA = has_next ? (const char*)g.A + (size_t)nxt.pm * tstep : cA; const char* nB = has_next ? (const char*)g.Bt + (size_t)nxt.pn * tstep : cB;
        for (int t = 0; t < nt; t += 2) {
            const bool last = (t == nt - 2);
            const char* a1 = cA + (size_t)(t + 1) * kstep;
            const char* a2 = last ? nA : cA + (size_t)(t + 2) * kstep; const char* b2 = last ? nB : cB + (size_t)(t + 2) * kstep;
            const char* a3 = a2 + kstep; const char* b3 = b2 + kstep;
            if (last && has_next) S.a_ready(nxt);
            if constexpr (SP2) {
            PG8_LDB(B0, 0, 0); PG8_LDB(B1, 0, 1); PG8_SCHED; PG8_LDA(At, 0, 0); PG8_STAGE(PG8_SA(1, 1), a1 + hstep, voffA);
            PG8_WAIT_V(8); PG8_WAIT_L(0); PG8_BAR; PG8_MMA(0, 0, At, B0); PG8_MMA(0, 1, At, B1); PG8_BAR; PG8_SCHED;
            PG8_LDA(At, 0, 1); PG8_STAGE(PG8_SB(0, 0), b2, voffB); PG8_STAGE(PG8_SB(0, 1), b2 + hstep, voffB); PG8_STAGE(PG8_SA(0, 0), a2, voffA);
            PG8_WAIT_V(8); PG8_WAIT_L(0); PG8_BAR; PG8_MMA(1, 0, At, B0); PG8_MMA(1, 1, At, B1); PG8_BAR; PG8_SCHED;
            PG8_LDB(B0, 1, 0); PG8_LDB(B1, 1, 1); PG8_SCHED; PG8_LDA(At, 1, 0); PG8_STAGE(PG8_SA(0, 1), a2 + hstep, voffA);
            PG8_WAIT_V(8); PG8_WAIT_L(0); PG8_BAR; PG8_MMA(0, 0, At, B0); PG8_MMA(0, 1, At, B1); PG8_BAR; PG8_SCHED;
            PG8_LDA(At, 1, 1); PG8_STAGE(PG8_SB(1, 0), b3, voffB); PG8_STAGE(PG8_SB(1, 1), b3 + hstep, voffB); PG8_STAGE(PG8_SA(1, 0), a3, voffA);
            PG8_WAIT_V(8); PG8_WAIT_L(0); PG8_BAR; PG8_MMA(1, 0, At, B0); PG8_MMA(1, 1, At, B1); PG8_BAR; PG8_SCHED;
            } else {
            PG8_LDB(B0, 0, 0); PG8_SCHED; PG8_LDA(At, 0, 0); PG8_STAGE(PG8_SA(1, 1), a1 + hstep, voffA);
            PG8_WAIT_L(8); PG8_BAR; PG8_WAIT_L(0); PG8_MMA(0, 0, At, B0); PG8_BAR; PG8_SCHED;
            PG8_LDB(B1, 0, 1); PG8_STAGE(PG8_SB(0, 0), b2, voffB);
            PG8_BAR; PG8_WAIT_L(0); PG8_MMA(0, 1, At, B1); PG8_BAR;
            PG8_LDA(At, 0, 1); PG8_STAGE(PG8_SA(0, 0), a2, voffA);
            PG8_BAR; PG8_WAIT_L(0); PG8_MMA(1, 0, At, B0); PG8_BAR; PG8_SCHED;
            PG8_STAGE(PG8_SB(0, 1), b2 + hstep, voffB);
            PG8_WAIT_V(6); PG8_BAR; PG8_MMA(1, 1, At, B1); PG8_BAR;
            PG8_LDB(B0, 1, 0); PG8_SCHED; PG8_LDA(At, 1, 0); PG8_STAGE(PG8_SA(0, 1), a2 + hstep, voffA);
            PG8_WAIT_L(8); PG8_BAR; PG8_WAIT_L(0); PG8_MMA(0, 0, At, B0); PG8_BAR; PG8_SCHED;
            PG8_LDB(B1, 1, 1); PG8_STAGE(PG8_SB(1, 0), b3, voffB);
            PG8_BAR; PG8_WAIT_L(0); PG8_MMA(0, 1, At, B1); PG8_BAR;
            PG8_LDA(At, 1, 1); PG8_STAGE(PG8_SA(1, 0), a3, voffA);
            PG8_BAR; PG8_WAIT_L(0); PG8_MMA(1, 0, At, B0); PG8_BAR; PG8_SCHED;
            PG8_STAGE(PG8_SB(1, 1), b3 + hstep, voffB);
            PG8_WAIT_V(6); PG8_BAR; PG8_MMA(1, 1, At, B1); PG8_BAR;
            }
        }
        if constexpr (ALIGN_EPI) { if (wr == 0) PG8_BAR; }
        if constexpr (!Epi::AFTER_DRAIN) { E(acc, cur, wr, wc, fr, fq); S.done(cur); }
        if (!has_next) break;
#pragma unroll
        for (int a = 0; a < 2; ++a)
#pragma unroll
            for (int b = 0; b < 2; ++b)
#pragma unroll
                for (int m = 0; m < 4; ++m)
#pragma unroll
                    for (int n = 0; n < 2; ++n) acc[a][b][m][n] = (f32x4){0.f, 0.f, 0.f, 0.f};
        cur = nxt; cA = nA; cB = nB; ++ui;
        if constexpr (ALIGN_EPI) { if (wr == 1) PG8_BAR; }
    }
    PG8_WAIT_V(0);
    if constexpr (!ALIGN_EPI) { if (wr == 0) PG8_BAR; }
    PG8_BAR;
    if constexpr (Epi::AFTER_DRAIN) { E.fused(acc, cur, wr, wc, fr, fq, lds, wid, lane); S.done(cur); }
#undef PG8_SA
#undef PG8_SB
#undef PG8_STAGE
#undef PG8_LDA
#undef PG8_LDB
#undef PG8_MMA
#undef PG8_WAIT_V
#undef PG8_WAIT_L
#undef PG8_BAR
#undef PG8_SCHED
}
}
namespace att {
using bf16 = unsigned short;
using bf16x8 = __attribute__((ext_vector_type(8))) short;
using s16x4 = __attribute__((ext_vector_type(4))) short;
using f32x16 = __attribute__((ext_vector_type(16))) float;
using u32x4 = __attribute__((ext_vector_type(4))) unsigned;
using f32x4 = __attribute__((ext_vector_type(4))) float;
constexpr int SEQ = 4096, PITCH = 2304, KVBLK = 64, NT = SEQ / KVBLK, NW = 8;
constexpr int NSLOT = 3, SLOTB = 8192;
constexpr int LDS_K = 0, LDS_V = NSLOT * SLOTB, LDS_WS = 2 * NSLOT * SLOTB, LDS_TBL = LDS_WS + NW * 256, LDS_OST = LDS_TBL + 2048, LDS_BYTES = LDS_OST + NW * 8192;
constexpr int TBL_N = 384, TBL_OFF = 192;
__device__ __forceinline__ int crow(int r, int hi) { return (r & 3) + 8 * (r >> 2) + 4 * hi; }
#define ATT_SBAR() __builtin_amdgcn_sched_barrier(0)
__device__ __forceinline__ void glds16(const void* gsrc, unsigned lds_dst) { unsigned keep;
  asm volatile("s_mov_b32 %0, m0\n\ts_mov_b32 m0, %2\n\ts_nop 0\n\tglobal_load_lds_dwordx4 %1, off\n\ts_mov_b32 m0, %0" : "=&s"(keep) : "v"(gsrc), "s"(lds_dst) : "memory"); }
typedef float f32x2_t __attribute__((ext_vector_type(2))); typedef __bf16 bf16x2_t __attribute__((ext_vector_type(2)));
__device__ __forceinline__ unsigned cvtpk_s(float lo, float hi) { f32x2_t v = {lo, hi}; bf16x2_t b = __builtin_convertvector(v, bf16x2_t); return __builtin_bit_cast(unsigned, b); }
__device__ __forceinline__ void pv(f32x16* o, int vb, bf16x8 pa0, bf16x8 pa1, bf16x8 pa2, bf16x8 pa3) {
  #pragma unroll
  for (int d0 = 0; d0 < 2; ++d0) { s16x4 lo[4], hi[4];
    #pragma unroll
    for (int ks = 0; ks < 4; ++ks) {
      asm volatile("ds_read_b64_tr_b16 %0,%1 offset:%c2" : "=&v"(lo[ks]) : "v"(vb), "i"(d0 * 4096 + ks * 1024) : "memory");
      asm volatile("ds_read_b64_tr_b16 %0,%1 offset:%c2" : "=&v"(hi[ks]) : "v"(vb), "i"(d0 * 4096 + ks * 1024 + 512) : "memory"); }
    asm volatile("s_waitcnt lgkmcnt(0)" ::: "memory"); ATT_SBAR();
    #define ATT_PK(k) (bf16x8){lo[k][0], lo[k][1], lo[k][2], lo[k][3], hi[k][0], hi[k][1], hi[k][2], hi[k][3]}
    o[d0] = __builtin_amdgcn_mfma_f32_32x32x16_bf16(pa0, ATT_PK(0), o[d0], 0, 0, 0);
    o[d0] = __builtin_amdgcn_mfma_f32_32x32x16_bf16(pa1, ATT_PK(1), o[d0], 0, 0, 0);
    o[d0] = __builtin_amdgcn_mfma_f32_32x32x16_bf16(pa2, ATT_PK(2), o[d0], 0, 0, 0);
    o[d0] = __builtin_amdgcn_mfma_f32_32x32x16_bf16(pa3, ATT_PK(3), o[d0], 0, 0, 0);
    #undef ATT_PK
  }
}
typedef __attribute__((address_space(3))) const char* lds_cptr;
typedef __attribute__((address_space(3))) float* lds_fptr;

template <bool MODEA>
__device__ __forceinline__ void attn_unit_simple(int b, int h, int qb, const bf16* QKV, bf16* AO, char* shm, const float* bias_tab, float lam, const float* subln) {
  const int tid = threadIdx.x, lane = tid & 63, r32 = lane & 31, hi = lane >> 5; const int wid = __builtin_amdgcn_readfirstlane(tid >> 6);
  const int part = MODEA ? (wid >> 2) : 0, w4 = MODEA ? (wid & 3) : wid;
  const int q0 = MODEA ? qb * 128 : qb * 256, qw0 = q0 + 32 * w4;
  const long rowbase = (long)b * SEQ;
  const int qcol = MODEA ? h * 64 + 32 * part : 1536 + h * 64;
  const int kcol = MODEA ? 512 + h * 64 : 2048 + (h >> 2) * 64;
  const int vcol = MODEA ? 1024 + h * 64 : 2176 + (h >> 2) * 64;
  constexpr int NDK = MODEA ? 2 : 4;
  const bf16* Qw = QKV + (rowbase + qw0) * PITCH + qcol;
  const bf16* Kh = QKV + rowbase * PITCH + kcol; const bf16* Vh = QKV + rowbase * PITCH + vcol;
  const unsigned lds0 = (unsigned)(uintptr_t)shm;
  const lds_cptr shm3 = (lds_cptr)shm;
  lds_fptr wsf = (lds_fptr)(shm3 + LDS_WS) + wid * 64;
  lds_fptr tbl = (lds_fptr)(shm3 + LDS_TBL);
  const bf16* ksrc = Kh + (long)lane * PITCH + wid * 8;
  const bf16* vsrc = Vh + (long)(16 * (wid & 3) + (lane >> 2)) * PITCH + (wid >> 2) * 32 + (lane & 3) * 8;
  const unsigned kdst = lds0 + LDS_K + wid * 1024, vdst = lds0 + LDS_V + wid * 1024;
  const int vb0 = (int)(lds0 + LDS_V) + ((lane >> 4) & 1) * 32 + (lane & 3) * 8 + (4 * hi + ((lane & 15) >> 2)) * 64;
  const lds_cptr kp0 = shm3 + LDS_K + part * 4096 + hi * 1024 + r32 * 16;
  if (MODEA) { if (tid < TBL_N) tbl[tid] = bias_tab[h * TBL_N + tid]; }
  bf16x8 qr[NDK];
  #pragma unroll
  for (int d0 = 0; d0 < NDK; ++d0) qr[d0] = *reinterpret_cast<const bf16x8*>(&Qw[(long)r32 * PITCH + d0 * 16 + hi * 8]);
  float m_run = -1e30f, l_reg = 0.f; f32x16 o[2]; o[0] = f32x16{}; o[1] = f32x16{};
  float cL = 0.f, cR = 0.f;
  for (int t = 0; t < NT; ++t) {
    asm volatile("s_waitcnt lgkmcnt(0)\n\ts_barrier" ::: "memory");
    glds16(ksrc + (long)t * KVBLK * PITCH, (unsigned)__builtin_amdgcn_readfirstlane(kdst));
    glds16(vsrc + (long)t * KVBLK * PITCH, (unsigned)__builtin_amdgcn_readfirstlane(vdst));
    asm volatile("s_waitcnt vmcnt(0)\n\ts_barrier" ::: "memory");
    if (MODEA && t == 0) { cL = tbl[0]; cR = tbl[TBL_N - 1]; }
    f32x16 p0, p1;
    #pragma unroll
    for (int d0 = 0; d0 < NDK; ++d0) {
      const bf16x8 b0 = *(const __attribute__((address_space(3))) bf16x8*)(kp0 + d0 * 2048);
      const bf16x8 b1 = *(const __attribute__((address_space(3))) bf16x8*)(kp0 + d0 * 2048 + 512);
      if (d0 == 0) { p0 = __builtin_amdgcn_mfma_f32_32x32x16_bf16(b0, qr[0], f32x16{}, 0, 0, 0); p1 = __builtin_amdgcn_mfma_f32_32x32x16_bf16(b1, qr[0], f32x16{}, 0, 0, 0); }
      else { p0 = __builtin_amdgcn_mfma_f32_32x32x16_bf16(b0, qr[d0], p0, 0, 0, 0); p1 = __builtin_amdgcn_mfma_f32_32x32x16_bf16(b1, qr[d0], p1, 0, 0, 0); }
    }
    if (MODEA) {
      const int kt = t * KVBLK;
      if (kt + 63 - qw0 <= -91) {
        #pragma unroll
        for (int r = 0; r < 16; ++r) { p0[r] += cL; p1[r] += cL; }
      } else if (kt - (qw0 + 31) >= 91) {
        #pragma unroll
        for (int r = 0; r < 16; ++r) { p0[r] += cR; p1[r] += cR; }
      } else {
        const lds_fptr tb = tbl + (kt - (qw0 + r32) + TBL_OFF + 4 * hi);
        #pragma unroll
        for (int r = 0; r < 16; ++r) { p0[r] += tb[(r & 3) + 8 * (r >> 2)]; p1[r] += tb[32 + (r & 3) + 8 * (r >> 2)]; }
      }
    }
    float rm = fmaxf(p0[0], p1[0]);
    #pragma unroll
    for (int r = 1; r < 16; ++r) rm = fmaxf(rm, fmaxf(p0[r], p1[r]));
    { auto rr = __builtin_amdgcn_permlane32_swap(__float_as_uint(rm), __float_as_uint(rm), false, false); rm = fmaxf(__uint_as_float(rr[0]), __uint_as_float(rr[1])); }
    const float mnew = fmaxf(m_run, rm);
    if (__any(mnew > m_run)) {
      const float alpha = __builtin_amdgcn_exp2f(m_run - mnew);
      l_reg *= alpha; m_run = mnew;
      if (hi == 0) wsf[r32] = alpha;
      asm volatile("s_waitcnt lgkmcnt(0)" ::: "memory");
      #pragma unroll
      for (int d = 0; d < 2; ++d)
        #pragma unroll
        for (int r = 0; r < 16; ++r) o[d][r] *= wsf[crow(r, hi)];
    }
    float sacc = 0.f;
    #pragma unroll
    for (int r = 0; r < 16; ++r) { p0[r] = __builtin_amdgcn_exp2f(p0[r] - m_run); p1[r] = __builtin_amdgcn_exp2f(p1[r] - m_run); sacc += p0[r] + p1[r]; }
    l_reg += sacc;
    u32x4 pw0, pw1, pw2, pw3;
    pw0 = (u32x4){cvtpk_s(p0[0], p0[1]), cvtpk_s(p0[2], p0[3]), cvtpk_s(p0[4], p0[5]), cvtpk_s(p0[6], p0[7])};
    pw1 = (u32x4){cvtpk_s(p0[8], p0[9]), cvtpk_s(p0[10], p0[11]), cvtpk_s(p0[12], p0[13]), cvtpk_s(p0[14], p0[15])};
    pw2 = (u32x4){cvtpk_s(p1[0], p1[1]), cvtpk_s(p1[2], p1[3]), cvtpk_s(p1[4], p1[5]), cvtpk_s(p1[6], p1[7])};
    pw3 = (u32x4){cvtpk_s(p1[8], p1[9]), cvtpk_s(p1[10], p1[11]), cvtpk_s(p1[12], p1[13]), cvtpk_s(p1[14], p1[15])};
    ATT_SBAR();
    pv(o, vb0, __builtin_bit_cast(bf16x8, pw0), __builtin_bit_cast(bf16x8, pw1), __builtin_bit_cast(bf16x8, pw2), __builtin_bit_cast(bf16x8, pw3));
  }
  { auto rr = __builtin_amdgcn_permlane32_swap(__float_as_uint(l_reg), __float_as_uint(l_reg), false, false); l_reg = __uint_as_float(rr[0]) + __uint_as_float(rr[1]); }
  if (hi == 0) wsf[32 + r32] = l_reg;
  asm volatile("s_waitcnt lgkmcnt(0)" ::: "memory");
  float rli[16];
  #pragma unroll
  for (int r = 0; r < 16; ++r) rli[r] = __builtin_amdgcn_rcpf(wsf[32 + crow(r, hi)]);
  if (!MODEA) {
    bf16* Ow = AO + (rowbase + qw0) * 1024 + 512 + h * 64;
    __attribute__((address_space(3))) bf16* stg = (__attribute__((address_space(3))) bf16*)(shm3 + LDS_OST) + wid * 4096;
    #pragma unroll
    for (int r = 0; r < 16; ++r) { const int orow = crow(r, hi);
      #pragma unroll
      for (int d0 = 0; d0 < 2; ++d0) stg[orow * 64 + d0 * 32 + r32] = (bf16)(cvtpk_s(o[d0][r] * rli[r], 0.f) & 0xffffu); }
    asm volatile("s_waitcnt lgkmcnt(0)" ::: "memory");
    #pragma unroll
    for (int i = 0; i < 4; ++i) { const int row = i * 8 + (lane >> 3), ch = lane & 7; const u32x4 v = *(const __attribute__((address_space(3))) u32x4*)(stg + row * 64 + ch * 8); *(u32x4*)(Ow + (long)row * 1024 + ch * 8) = v; }
  } else {
    lds_fptr stg = (lds_fptr)(shm3 + LDS_OST) + wid * 2048;
    #pragma unroll
    for (int r = 0; r < 16; ++r) { const int orow = crow(r, hi);
      #pragma unroll
      for (int d0 = 0; d0 < 2; ++d0) stg[orow * 64 + d0 * 32 + r32] = o[d0][r] * rli[r]; }
    asm volatile("s_waitcnt lgkmcnt(0)\n\ts_barrier" ::: "memory");
    const lds_fptr s1 = (lds_fptr)(shm3 + LDS_OST) + w4 * 2048, s2 = s1 + 4 * 2048;
    bf16* Ow = AO + (rowbase + q0 + 32 * w4) * 1024 + h * 64;
    #pragma unroll
    for (int i = 0; i < 2; ++i) {
      const int row = 16 * part + i * 8 + (lane >> 3), ch = lane & 7;
      const f32x4 a0 = *(const __attribute__((address_space(3))) f32x4*)(s1 + row * 64 + ch * 8), a1 = *(const __attribute__((address_space(3))) f32x4*)(s1 + row * 64 + ch * 8 + 4);
      const f32x4 b0 = *(const __attribute__((address_space(3))) f32x4*)(s2 + row * 64 + ch * 8), b1 = *(const __attribute__((address_space(3))) f32x4*)(s2 + row * 64 + ch * 8 + 4);
      const f32x4 d0v = a0 - b0 * lam, d1v = a1 - b1 * lam;
      float q = ((d0v[0] * d0v[0] + d0v[1] * d0v[1]) + (d0v[2] * d0v[2] + d0v[3] * d0v[3])) + ((d1v[0] * d1v[0] + d1v[1] * d1v[1]) + (d1v[2] * d1v[2] + d1v[3] * d1v[3]));
      q += __shfl_xor(q, 1); q += __shfl_xor(q, 2); q += __shfl_xor(q, 4);
      const float rs = rsqrtf(q * (1.0f / 64.0f) + 1e-6f) * 0.8f;
      const f32x4 g0 = *(const f32x4*)(subln + ch * 8), g1 = *(const f32x4*)(subln + ch * 8 + 4);
      const f32x4 y0 = d0v * rs * g0, y1 = d1v * rs * g1;
      u32x4 w; w.x = cvtpk_s(y0[0], y0[1]); w.y = cvtpk_s(y0[2], y0[3]); w.z = cvtpk_s(y1[0], y1[1]); w.w = cvtpk_s(y1[2], y1[3]);
      *(u32x4*)(Ow + (long)row * 1024 + ch * 8) = w;
    }
  }
  asm volatile("s_waitcnt lgkmcnt(0)\n\ts_barrier" ::: "memory");
}
#undef ATT_SBAR
}
#define LAS __attribute__((address_space(3)))
#define XB_TMO      128
#define XB_XCNT(j)  (256  + 64 * (j))
#define XB_XSUB(j)  (1280 + 64 * (j))
#define XB_XGEN(j)  (2304 + 64 * (j))
#define XB_TOP      3328
#define XB_TOPGEN   3392
#define XCD_BAR_WORDS 3456
#define XB_SPIN_CAP (1u << 18)

__device__ __forceinline__ unsigned xb_ld(unsigned* p)              { return __hip_atomic_load(p, __ATOMIC_RELAXED, __HIP_MEMORY_SCOPE_AGENT); }
__device__ __forceinline__ unsigned xb_add(unsigned* p, unsigned v) { return __hip_atomic_fetch_add(p, v, __ATOMIC_RELAXED, __HIP_MEMORY_SCOPE_AGENT); }
__device__ __forceinline__ unsigned xb_xcc_id() { return (unsigned)__builtin_amdgcn_s_getreg((3 << 11) | 20) & 0xFu; }
#define XB_SPIN(cond, bar) do { unsigned _sp = 0; while (cond) { __builtin_amdgcn_s_sleep(1); \
    if ((++_sp & 255u) == 0u) { if (xb_ld(&(bar)[XB_TMO])) break; if (_sp > XB_SPIN_CAP) { atomicAdd(&(bar)[XB_TMO], 1u); break; } } } } while (0)

struct XcdBarrier {
    unsigned* bar; unsigned x;
    volatile LAS unsigned* st;
};

__device__ __forceinline__ XcdBarrier xcd_barrier_post(unsigned* bar, volatile LAS unsigned* st) {
    XcdBarrier b; b.bar = bar; b.x = xb_xcc_id(); b.st = st;
    if (threadIdx.x == 0) (void)xb_add(&bar[XB_XCNT(b.x)], 1u);
    return b;
}
__device__ __forceinline__ void xcd_barrier_complete(unsigned* bar, unsigned x, unsigned& nloc, unsigned& nx) {
    const unsigned G = gridDim.x * gridDim.y * gridDim.z;
    unsigned sum, cnt, mine, sp = 0u;
    for (;;) {
        sum = 0u; cnt = 0u; mine = 0u;
#pragma unroll
        for (unsigned j = 0; j < 16; ++j) { const unsigned c = xb_ld(&bar[XB_XCNT(j)]); sum += c; cnt += (c > 0u) ? 1u : 0u; mine = (j == x) ? c : mine; }
        if (sum == G) break;
        __builtin_amdgcn_s_sleep(1);
        if ((++sp & 255u) == 0u) { if (xb_ld(&bar[XB_TMO])) break; if (sp > XB_SPIN_CAP) { atomicAdd(&bar[XB_TMO], 1u); break; } }
    }
    nloc = mine > 0u ? mine : 1u; nx = cnt > 0u ? cnt : 1u;
}

__device__ __forceinline__ void xcd_barrier(const XcdBarrier& b) {
    asm volatile("s_waitcnt vmcnt(0)" ::: "memory");
    __syncthreads();
    if (threadIdx.x == 0) {
        unsigned* bar = b.bar;
        __builtin_amdgcn_s_waitcnt(0);
        unsigned nloc = b.st[0], nx = b.st[1];
        if (nloc == 0u) { xcd_barrier_complete(bar, b.x, nloc, nx); b.st[0] = nloc; b.st[1] = nx; }
        const unsigned old = xb_add(&bar[XB_XSUB(b.x)], 1u);
        const unsigned gen = old / nloc;
        if (old + 1u == (gen + 1u) * nloc) {
            __builtin_amdgcn_fence(__ATOMIC_RELEASE, "agent");
            asm volatile("s_waitcnt vmcnt(0)" ::: "memory");
            const unsigned og = xb_add(&bar[XB_TOP], 1u);
            const unsigned tg = og / nx;
            if (og + 1u == (tg + 1u) * nx) xb_add(&bar[XB_TOPGEN], 1u);
            else XB_SPIN(xb_ld(&bar[XB_TOPGEN]) == tg, bar);
            __builtin_amdgcn_fence(__ATOMIC_ACQUIRE, "agent");
            xb_add(&bar[XB_XGEN(b.x)], 1u);
            asm volatile("s_waitcnt vmcnt(0)" ::: "memory");
        } else {
            XB_SPIN(xb_ld(&bar[XB_XGEN(b.x)]) == gen, bar);
            __builtin_amdgcn_fence(__ATOMIC_ACQUIRE, "agent");
            asm volatile("s_waitcnt vmcnt(0)" ::: "memory");
        }
    }
    __syncthreads();
}
constexpr int NWAVES = 8;
constexpr int BATCH = 8, SEQ = 4096, D = 1024, FF = 2816, DIN = 2304, M = BATCH * SEQ;
constexpr int NPH = 9;
constexpr size_t MiB = 1u << 20;
constexpr size_t WS_CTL = 0, CTL_ZERO_BYTES = 1 * MiB;
constexpr size_t WS_TAB = 1 * MiB;
constexpr size_t TAB_CS = 256, TAB_BIAS = 256 + 8192;
constexpr size_t WS_SS1 = 2 * MiB, WS_SS2 = 4 * MiB;
constexpr size_t WS_W1GU = 8 * MiB, WS_W1D = 20 * MiB, WS_WIN = 26 * MiB, WS_WOUT = 31 * MiB, WS_W2GU = 34 * MiB, WS_W2D = 46 * MiB;
constexpr size_t WS_A = 56 * MiB;
constexpr size_t WS_B = 232 * MiB;
constexpr size_t WS_C = 296 * MiB;
constexpr size_t WS_D = 360 * MiB;
constexpr size_t WS_END = 488 * MiB;
static_assert(WS_W1GU + (size_t)2 * FF * D * 2 <= WS_W1D && WS_W1D + (size_t)FF * D * 2 <= WS_WIN && WS_WIN + (size_t)DIN * D * 2 <= WS_WOUT && WS_WOUT + (size_t)D * D * 2 <= WS_W2GU &&
              WS_W2GU + (size_t)2 * FF * D * 2 <= WS_W2D && WS_W2D + (size_t)FF * D * 2 <= WS_A && WS_A + (size_t)M * FF * 2 <= WS_B && WS_SS2 + (size_t)M * 64 <= WS_W1GU, "d_ws map");
constexpr int CW_BAR = 4096;
constexpr int RING_OFF = 0, RING_BYTES = 131072;
constexpr int LDSCTL_OFF = RING_BYTES, MISC_OFF = LDSCTL_OFF + 320;
constexpr int LDS_BYTES = 147456;
static_assert(att::LDS_BYTES <= RING_BYTES, "attention scratch fits the ring region");

#define GAS __attribute__((address_space(1)))
typedef unsigned short bf16;
typedef unsigned v4u __attribute__((ext_vector_type(4)));
typedef float f32x4 __attribute__((ext_vector_type(4)));
#define LDS_WAIT() asm volatile("s_waitcnt lgkmcnt(0)" ::: "memory")
__device__ __forceinline__ unsigned f2bf(float f) { unsigned u = __builtin_bit_cast(unsigned, f); return (u + 0x7fffu + ((u >> 16) & 1u)) >> 16; }
__device__ __forceinline__ unsigned pk2(float lo, float hi) { return f2bf(lo) | (f2bf(hi) << 16); }
__device__ __forceinline__ float wave_sum(float v) {
#pragma unroll
    for (int o = 1; o < 64; o <<= 1) v += __shfl_xor(v, o);
    return v;
}

__device__ __forceinline__ void p0_transpose_item(const float* W, int K, int N, bf16* WT, int k0, int n0, int drow0, const float* g, LAS float* scr, int lane) {
#pragma unroll 8
    for (int i = 0; i < 32; ++i) { const int kk = 2 * i + (lane >> 5); float w = W[(size_t)(k0 + kk) * N + n0 + (lane & 31)]; if (g) w *= g[k0 + kk]; scr[kk * 33 + (lane & 31)] = w; }
    LDS_WAIT(); asm volatile("" ::: "memory");
    const int c = lane & 7;
#pragma unroll
    for (int j = 0; j < 4; ++j) { const int n = (lane >> 3) + 8 * j; const LAS float* s = scr + (8 * c) * 33 + n;
        v4u o; o.x = pk2(s[0 * 33], s[1 * 33]); o.y = pk2(s[2 * 33], s[3 * 33]); o.z = pk2(s[4 * 33], s[5 * 33]); o.w = pk2(s[6 * 33], s[7 * 33]);
        *(GAS v4u*)(WT + (size_t)(drow0 + n) * K + k0 + 8 * c) = o; }
    LDS_WAIT(); asm volatile("" ::: "memory");
}

struct Args { const float* in[21]; float* out; unsigned char* ws; int ph_lo, ph_hi; };

__device__ __forceinline__ int t5_bucket(int rel) {
    const int n = rel < 0 ? -rel : rel; int bk;
    if (n < 8) bk = n; else { const int l = 2 + (31 - __clz(n * n)); bk = l < 15 ? l : 15; }
    return bk + (rel > 0 ? 16 : 0);
}

__global__ void __launch_bounds__(NWAVES * 64, 2) mega_fwd(Args args) {
    extern __shared__ __attribute__((aligned(16))) unsigned char lds[];
    LAS unsigned char* ldsp = (LAS unsigned char*)lds;
    volatile LAS unsigned* MISC = (volatile LAS unsigned*)(ldsp + MISC_OFF);
    const int tid = threadIdx.x, lane = tid & 63, wave = __builtin_amdgcn_readfirstlane(tid >> 6);
    const int G = gridDim.x; const int bx = blockIdx.x; const int vcu = (G % 8 == 0) ? (bx % 8) * (G / 8) + bx / 8 : bx;
    unsigned char* ws = args.ws;
    unsigned* ctl = (unsigned*)(ws + WS_CTL);
    const float* x = args.in[0];
    float* out = args.out;
    float* misc = (float*)(ws + WS_TAB); float* cs = misc + TAB_CS / 4; float* bias_tab = misc + TAB_BIAS / 4;
    float* ss1 = (float*)(ws + WS_SS1); float* ss2 = (float*)(ws + WS_SS2);
    bf16* W1gu = (bf16*)(ws + WS_W1GU); bf16* W1d = (bf16*)(ws + WS_W1D); bf16* WinT = (bf16*)(ws + WS_WIN); bf16* WoutT = (bf16*)(ws + WS_WOUT); bf16* W2gu = (bf16*)(ws + WS_W2GU); bf16* W2d = (bf16*)(ws + WS_W2D);
    bf16* ACT = (bf16*)(ws + WS_A); bf16* QKV = (bf16*)(ws + WS_A);
    bf16* H1 = (bf16*)(ws + WS_B); bf16* X1b = (bf16*)(ws + WS_B); bf16* AO = (bf16*)(ws + WS_B);
    bf16* X2b = (bf16*)(ws + WS_C); float* X1 = (float*)(ws + WS_D);
    for (int u = tid; u < (LDS_BYTES - LDSCTL_OFF) / 4; u += NWAVES * 64) ((LAS unsigned*)(ldsp + LDSCTL_OFF))[u] = 0u;
    __syncthreads();
    XcdBarrier bar = xcd_barrier_post(ctl + CW_BAR, MISC + 8);
    const int lo = args.ph_lo, hi = args.ph_hi;
#define IN(k) (lo <= (k) && (k) < hi)
#define SEAM(k) do { if (IN(k) && IN((k) + 1)) xcd_barrier(bar); } while (0)
    const int gw = vcu * NWAVES + wave, NGW = G * NWAVES;

    if (IN(0)) {
        LAS float* scr = (LAS float*)(ldsp + RING_OFF + wave * 16384);
        constexpr int I_GU = (D / 64) * (FF / 32), I_DN = (FF / 64) * (D / 32), I_IN = (D / 64) * (DIN / 32), I_OUT = (D / 64) * (D / 32);
        constexpr int NITEMS = 4 * I_GU + 2 * I_DN + I_IN + I_OUT;
        for (int it = gw; it < NITEMS; it += NGW) {
            int r = it;
            if (r < 4 * I_GU) {
                const int which = r / I_GU; r -= which * I_GU; const int nblk = FF / 32, kb = r / nblk, nb = r % nblk, n0 = 32 * nb;
                const float* W = args.in[which == 0 ? 2 : which == 1 ? 3 : which == 2 ? 17 : 18];
                const int drow0 = 256 * (n0 / 128) + 128 * (which & 1) + (n0 % 128);
                p0_transpose_item(W, D, FF, which < 2 ? W1gu : W2gu, 64 * kb, n0, drow0, which < 2 ? nullptr : args.in[16], scr, lane); continue; }
            r -= 4 * I_GU;
            if (r < 2 * I_DN) { const int which = r / I_DN; r -= which * I_DN; const int nblk = D / 32, kb = r / nblk, nb = r % nblk;
                p0_transpose_item(args.in[which ? 19 : 4], FF, D, which ? W2d : W1d, 64 * kb, 32 * nb, 32 * nb, nullptr, scr, lane); continue; }
            r -= 2 * I_DN;
            if (r < I_IN) { const int nblk = DIN / 32, kb = r / nblk, nb = r % nblk, n0 = 32 * nb;
                const int drow0 = 256 * (n0 / 256) + 128 * ((n0 % 64) / 32) + 32 * ((n0 % 256) / 64);
                p0_transpose_item(args.in[6], D, DIN, WinT, 64 * kb, n0, drow0, args.in[5], scr, lane); continue; }
            r -= I_IN;
            { const int nblk = D / 32, kb = r / nblk, nb = r % nblk; p0_transpose_item(args.in[15], D, D, WoutT, 64 * kb, 32 * nb, 32 * nb, nullptr, scr, lane); }
        }
        { const int gt = vcu * NWAVES * 64 + tid;
          if (gt < 1024) { const int pos = gt >> 4, f = gt & 15; const float inv = powf(10000.0f, -(float)f / 16.0f); const float ang = (float)pos * inv; cs[2 * gt] = cosf(ang); cs[2 * gt + 1] = sinf(ang); }
          else if (gt < 1024 + 8 * att::TBL_N) { const int i = gt - 1024, h = i / att::TBL_N, rel = i % att::TBL_N - att::TBL_OFF; bias_tab[i] = args.in[14][t5_bucket(rel) * 8 + h] * 1.4426950408889634f; }
          else if (gt == 1024 + 8 * att::TBL_N) { float s1 = 0.f, s2 = 0.f; for (int d = 0; d < 32; ++d) { s1 += args.in[7][d] * args.in[8][d]; s2 += args.in[9][d] * args.in[10][d]; } misc[0] = expf(s1) - expf(s2) + 0.2f; } }
        for (int m = gw; m < M; m += NGW) {
            const GAS f32x4* xr = (const GAS f32x4*)(x + (size_t)m * D) + lane; const f32x4* gr = (const f32x4*)args.in[1] + lane;
            f32x4 v[4]; float s = 0.f;
#pragma unroll
            for (int j = 0; j < 4; ++j) { v[j] = xr[64 * j]; s += (v[j].x * v[j].x + v[j].y * v[j].y) + (v[j].z * v[j].z + v[j].w * v[j].w); }
            const float rstd = rsqrtf(wave_sum(s) * (1.f / D) + 1e-6f);
            GAS unsigned long long* o8 = (GAS unsigned long long*)(H1 + (size_t)m * D) + lane;
#pragma unroll
            for (int j = 0; j < 4; ++j) { const f32x4 gg = gr[64 * j]; o8[64 * j] = (unsigned long long)pk2(v[j].x * rstd * gg.x, v[j].y * rstd * gg.y) | ((unsigned long long)pk2(v[j].z * rstd * gg.z, v[j].w * rstd * gg.w) << 32); }
        }
    }
    SEAM(0);
    if (IN(1)) { pg8::Gemm g{H1, W1gu, M, 2 * FF, D}; pg8::StaticOrder S; S.init(M, 2 * FF, G, bx); pg8::EpiSwiGLU<false> E{ACT, FF, nullptr};
        pg8::gemm_phase<pg8::EpiSwiGLU<false>, pg8::StaticOrder, true, true>(ldsp + RING_OFF, g, S, E); }
    SEAM(1);
    if (IN(2)) { pg8::Gemm g{ACT, W1d, M, D, FF}; pg8::StaticOrder S; S.init(M, D, G, bx); pg8::EpiResid<true> E{x, X1, X1b, ss1, 0.5f};
        pg8::gemm_phase<pg8::EpiResid<true>, pg8::StaticOrder, true, true>(ldsp + RING_OFF, g, S, E); }
    SEAM(2);
    if (IN(3)) { pg8::Gemm g{X1b, WinT, M, DIN, D}; pg8::StaticOrder S; S.init(M, DIN, G, bx); pg8::EpiProj E{QKV, ss1, args.in[12], args.in[13], cs};
        pg8::gemm_phase<pg8::EpiProj, pg8::StaticOrder, true, true>(ldsp + RING_OFF, g, S, E); }
    SEAM(3);
    if (IN(4)) {
        const float lam = misc[0];
        { const int NU = BATCH * 8 * 32, upc = (NU + G - 1) / G;
          for (int i = 0; i < upc; ++i) { const int u = vcu * upc + i; if (u >= NU) break; const int bh = u >> 5, qb = u & 31;
              att::attn_unit_simple<true>(bh >> 3, bh & 7, qb, QKV, AO, (char*)lds + RING_OFF, bias_tab, lam, args.in[11]); } }
        { const int NU = BATCH * 8 * 16, upc = (NU + G - 1) / G;
          for (int i = 0; i < upc; ++i) { const int u = vcu * upc + i; if (u >= NU) break; const int bh = u >> 4, qb = u & 15;
              att::attn_unit_simple<false>(bh >> 3, bh & 7, qb, QKV, AO, (char*)lds + RING_OFF, bias_tab, lam, args.in[11]); } }
    }
    SEAM(4);
    if (IN(5)) { pg8::Gemm g{AO, WoutT, M, D, D}; pg8::StaticOrder S; S.init(M, D, G, bx); pg8::EpiResid<true> E{X1, out, X2b, ss2, 1.0f};
        pg8::gemm_phase<pg8::EpiResid<true>, pg8::StaticOrder, true, true>(ldsp + RING_OFF, g, S, E); }
    SEAM(5);
    if (IN(6)) { pg8::Gemm g{X2b, W2gu, M, 2 * FF, D}; pg8::StaticOrder S; S.init(M, 2 * FF, G, bx); pg8::EpiSwiGLU<true> E{ACT, FF, ss2};
        pg8::gemm_phase<pg8::EpiSwiGLU<true>, pg8::StaticOrder, true, true>(ldsp + RING_OFF, g, S, E); }
    SEAM(6);
    if (IN(7)) { pg8::Gemm g{ACT, W2d, M, D, FF}; pg8::StaticOrder S; S.init(M, D, G, bx); pg8::EpiResid<false> E{out, out, nullptr, nullptr, 0.5f};
        pg8::gemm_phase<pg8::EpiResid<false>, pg8::StaticOrder, true, true>(ldsp + RING_OFF, g, S, E); }
    SEAM(7);
    if (IN(8)) {
        for (int m = gw; m < M; m += NGW) {
            GAS f32x4* xr = (GAS f32x4*)(out + (size_t)m * D) + lane; const f32x4* gr = (const f32x4*)args.in[20] + lane;
            f32x4 v[4]; float s = 0.f;
#pragma unroll
            for (int j = 0; j < 4; ++j) { v[j] = xr[64 * j]; s += (v[j].x * v[j].x + v[j].y * v[j].y) + (v[j].z * v[j].z + v[j].w * v[j].w); }
            const float rstd = rsqrtf(wave_sum(s) * (1.f / D) + 1e-6f);
#pragma unroll
            for (int j = 0; j < 4; ++j) { const f32x4 gg = gr[64 * j]; xr[64 * j] = v[j] * rstd * gg; }
        }
    }
#undef IN
#undef SEAM
}

extern "C" void kernel_launch(void* const* d_in, const int* in_sizes, int n_in, void* d_out, int out_size, void* d_ws, size_t ws_size, hipStream_t stream) {
    static int grid = 0;
    if (grid == 0) {
        if (n_in != 21 || in_sizes[0] != M * D || out_size != M * D || ws_size < WS_END) { fprintf(stderr, "kernel_launch: unexpected shapes (n_in %d, in0 %d, out %d, ws %zu)\n", n_in, n_in > 0 ? in_sizes[0] : -1, out_size, ws_size); grid = -1; return; }
        int dev = 0, cus = 0, per_cu = 0;
        if (hipGetDevice(&dev) != hipSuccess || hipDeviceGetAttribute(&cus, hipDeviceAttributeMultiprocessorCount, dev) != hipSuccess) { grid = -1; return; }
        if (hipFuncSetAttribute((const void*)mega_fwd, hipFuncAttributeMaxDynamicSharedMemorySize, LDS_BYTES) != hipSuccess) { fprintf(stderr, "kernel_launch: hipFuncSetAttribute failed\n"); grid = -1; return; }
        if (hipOccupancyMaxActiveBlocksPerMultiprocessor(&per_cu, (const void*)mega_fwd, NWAVES * 64, LDS_BYTES) != hipSuccess || per_cu < 1) { fprintf(stderr, "kernel_launch: occupancy query reports %d workgroups per CU\n", per_cu); (void)hipGetLastError(); grid = -1; return; }
        grid = cus;
    }
    if (grid < 0) return;
    if (hipMemsetAsync((char*)d_ws + WS_CTL, 0, CTL_ZERO_BYTES, stream) != hipSuccess) return;
    Args a{};
    for (int i = 0; i < 21; ++i) a.in[i] = (const float*)d_in[i];
    a.out = (float*)d_out; a.ws = (unsigned char*)d_ws; a.ph_lo = 0; a.ph_hi = NPH;
    hipLaunchKernelGGL(mega_fwd, dim3(grid), dim3(NWAVES * 64), LDS_BYTES, stream, a);
}
```

```cpp
#include <hip/hip_runtime.h>
#include <cstdio>
#include <cstdint>
#include <cmath>
namespace pg8 {
#define PG8_LAS __attribute__((address_space(3)))
typedef unsigned short bf16_t;
typedef short bf16x8 __attribute__((ext_vector_type(8)));
typedef float f32x4 __attribute__((ext_vector_type(4)));
typedef unsigned u32x4 __attribute__((ext_vector_type(4)));
constexpr int BM = 256, BK = 64, HALF = 128, HTB = HALF * BK * 2  , STAGE_BYTES = 8 * HTB, NXCD = 8, WGM = 8;

__host__ __device__ __forceinline__ int lds_byte(int r, int c) { const int st = (r >> 4) * 2 + (c >> 5), rr = r & 15, cc = c & 31, ob = rr * 64 + cc * 2; return st * 1024 + (ob ^ (((ob >> 9) & 1) << 5)); }
__host__ __device__ __forceinline__ void stage_rc(int b, int& R, int& C) { const int st = b / 1024, sb = b % 1024, swz = sb ^ (((sb >> 9) & 1) << 5); R = (st >> 1) * 16 + swz / 64; C = (st & 1) * 32 + (swz % 64) / 2; }
__host__ __device__ __forceinline__ int perm32(int rho) { const int n = rho >> 4, i = rho & 15; return 8 * (i >> 2) + 4 * n + (i & 3); }

struct Unit { int pm, pn; };
struct Gemm { const bf16_t* A; const bf16_t* Bt; int M, N, K; };

struct StaticOrder {
    int nM, nN, nwg, G, c;
    __host__ __device__ void init(int M, int N, int G_, int c_) { nM = M / BM; nN = N / BM; nwg = nM * nN; G = G_; c = c_; }
    __host__ __device__ bool next(int i, Unit& u) const {
        const long L = (long)i * G + c; if (L >= nwg) return false;
        int wgid = (int)L; { const int q = nwg / NXCD, r = nwg % NXCD, xcd = wgid % NXCD, off = wgid / NXCD; wgid = (xcd < r ? xcd * (q + 1) : r * (q + 1) + (xcd - r) * q) + off; }
        const int nig = WGM * nN, gid = wgid / nig, fm = gid * WGM, gsz = (nM - fm) < WGM ? (nM - fm) : WGM;
        u.pm = fm + ((wgid % nig) % gsz); u.pn = (wgid % nig) / gsz; return true;
    }
    __device__ __forceinline__ void a_ready(const Unit&) const {}
    __device__ __forceinline__ void done(const Unit&) const {}
};

__device__ __forceinline__ unsigned cvt_pk_bf16(float lo, float hi) { unsigned r; asm volatile("v_cvt_pk_bf16_f32 %0, %1, %2" : "=v"(r) : "v"(lo), "v"(hi)); return r; }
constexpr float RMS_EPS = 1e-6f;
__device__ __forceinline__ float rstd_from_parts(const float* ss, int row) {
    const f32x4* p = (const f32x4*)(ss + (size_t)row * 16);
    const f32x4 a = p[0], b = p[1], c = p[2], d = p[3];
    const float s = (((a[0] + a[1]) + (a[2] + a[3])) + ((b[0] + b[1]) + (b[2] + b[3]))) + (((c[0] + c[1]) + (c[2] + c[3])) + ((d[0] + d[1]) + (d[2] + d[3])));
    return rsqrtf(s * (1.0f / 1024.0f) + RMS_EPS);
}
__device__ __forceinline__ float silu_mul(float g, float u) { return g * __builtin_amdgcn_rcpf(1.0f + __builtin_amdgcn_exp2f(-1.4426950408889634f * g)) * u; }

template <bool RS> struct EpiSwiGLU {
    static constexpr bool PERM = true, AFTER_DRAIN = false;
    bf16_t* O; int ldo; const float* ss;
    __device__ __forceinline__ void operator()(const f32x4 (&acc)[2][2][4][2], const Unit& u, int wr, int wc, int fr, int fq) const {
        const int row0 = u.pm * BM + wr * 64 + fr, col0 = u.pn * HALF + wc * 32 + 8 * fq;
#pragma unroll
        for (int ai = 0; ai < 2; ++ai)
#pragma unroll
            for (int m = 0; m < 4; ++m) {
                const int row = row0 + ai * HALF + m * 16;
                const float rs = RS ? rstd_from_parts(ss, row) : 1.0f;
                const f32x4 g0 = acc[ai][0][m][0] * rs, g1 = acc[ai][0][m][1] * rs, u0 = acc[ai][1][m][0] * rs, u1 = acc[ai][1][m][1] * rs;
                u32x4 w;
                w.x = cvt_pk_bf16(silu_mul(g0[0], u0[0]), silu_mul(g0[1], u0[1])); w.y = cvt_pk_bf16(silu_mul(g0[2], u0[2]), silu_mul(g0[3], u0[3]));
                w.z = cvt_pk_bf16(silu_mul(g1[0], u1[0]), silu_mul(g1[1], u1[1])); w.w = cvt_pk_bf16(silu_mul(g1[2], u1[2]), silu_mul(g1[3], u1[3]));
                *(u32x4*)(O + (size_t)row * ldo + col0) = w;
            }
    }
};

template <bool WB> struct EpiResid {
    static constexpr bool PERM = true, AFTER_DRAIN = false;
    const float* R; float* Xf; bf16_t* Xb; float* ss; float alpha;
    __device__ __forceinline__ void operator()(const f32x4 (&acc)[2][2][4][2], const Unit& u, int wr, int wc, int fr, int fq) const {
        const int row0 = u.pm * BM + wr * 64 + fr, col0 = u.pn * BM + wc * 32 + 8 * fq;
#pragma unroll
        for (int ai = 0; ai < 2; ++ai)
#pragma unroll
            for (int m = 0; m < 4; ++m) {
                const int row = row0 + ai * HALF + m * 16; const size_t off = (size_t)row * 1024 + col0; float q = 0.f;
#pragma unroll
                for (int bj = 0; bj < 2; ++bj) {
                    const f32x4 r0 = *(const f32x4*)(R + off + bj * HALF), r1 = *(const f32x4*)(R + off + bj * HALF + 4);
                    const f32x4 v0 = r0 + acc[ai][bj][m][0] * alpha, v1 = r1 + acc[ai][bj][m][1] * alpha;
                    *(f32x4*)(Xf + off + bj * HALF) = v0; *(f32x4*)(Xf + off + bj * HALF + 4) = v1;
                    if (WB) { u32x4 w; w.x = cvt_pk_bf16(v0[0], v0[1]); w.y = cvt_pk_bf16(v0[2], v0[3]); w.z = cvt_pk_bf16(v1[0], v1[1]); w.w = cvt_pk_bf16(v1[2], v1[3]);
                        *(u32x4*)(Xb + off + bj * HALF) = w;
                        q += ((v0[0] * v0[0] + v0[1] * v0[1]) + (v0[2] * v0[2] + v0[3] * v0[3])) + ((v1[0] * v1[0] + v1[1] * v1[1]) + (v1[2] * v1[2] + v1[3] * v1[3])); }
                }
                if (WB) { q += __shfl_xor(q, 16); q += __shfl_xor(q, 32); if (fq == 0) ss[(size_t)row * 16 + u.pn * 4 + wc] = q; }
                asm volatile("" ::: "memory");
            }
    }
};

constexpr float C2A = 0.17677669529663687f * 1.4426950408889634f;
constexpr float C2B = 0.125f * 1.4426950408889634f;
struct EpiProj {
    static constexpr bool PERM = true, AFTER_DRAIN = false;
    bf16_t* O; const float* ss; const float* qn; const float* kn; const float* cs;
    __device__ __forceinline__ void operator()(const f32x4 (&acc)[2][2][4][2], const Unit& u, int wr, int wc, int fr, int fq) const {
        const int pn = u.pn, row0 = u.pm * BM + wr * 64 + fr, colbase = pn * 256 + wc * 64 + 8 * fq;
        int mode = 0; float qscale = 1.0f; const float* gain = qn;
        if (pn < 2) { mode = 1; qscale = C2A; } else if (pn < 6) { mode = 0; } else if (pn < 8) { mode = 2; qscale = C2B; } else if (wc < 2) { mode = 2; gain = kn; }
        f32x4 gv[2][2];
#pragma unroll
        for (int bj = 0; bj < 2; ++bj)
#pragma unroll
            for (int n = 0; n < 2; ++n) gv[bj][n] = (mode == 2) ? *(const f32x4*)(gain + 32 * bj + 8 * fq + 4 * n) : (f32x4){1.f, 1.f, 1.f, 1.f};
#pragma unroll
        for (int ai = 0; ai < 2; ++ai)
#pragma unroll
            for (int m = 0; m < 4; ++m) {
                const int row = row0 + ai * HALF + m * 16;
                const float rs = rstd_from_parts(ss, row);
                f32x4 v[2][2];
#pragma unroll
                for (int bj = 0; bj < 2; ++bj)
#pragma unroll
                    for (int n = 0; n < 2; ++n) v[bj][n] = acc[ai][bj][m][n] * rs;
                if (mode == 2) {
                    float q = 0.f;
#pragma unroll
                    for (int bj = 0; bj < 2; ++bj)
#pragma unroll
                        for (int n = 0; n < 2; ++n) q += (v[bj][n][0] * v[bj][n][0] + v[bj][n][1] * v[bj][n][1]) + (v[bj][n][2] * v[bj][n][2] + v[bj][n][3] * v[bj][n][3]);
                    q += __shfl_xor(q, 16); q += __shfl_xor(q, 32);
                    const float hr = rsqrtf(q * (1.0f / 64.0f) + RMS_EPS);
                    const int s = row & 4095;
#pragma unroll
                    for (int bj = 0; bj < 2; ++bj) {
                        const int pos = bj ? (s & 63) : (s >> 6);
                        const f32x4* t = (const f32x4*)(cs + (size_t)(pos * 16 + 4 * fq) * 2);
#pragma unroll
                        for (int n = 0; n < 2; ++n) {
                            const f32x4 x = v[bj][n] * hr * gv[bj][n], c = t[n];
                            f32x4 y; y[0] = x[0] * c[0] - x[1] * c[1]; y[1] = x[0] * c[1] + x[1] * c[0]; y[2] = x[2] * c[2] - x[3] * c[3]; y[3] = x[2] * c[3] + x[3] * c[2];
                            v[bj][n] = y * qscale;
                        }
                    }
                } else if (mode == 1) {
#pragma unroll
                    for (int bj = 0; bj < 2; ++bj)
#pragma unroll
                        for (int n = 0; n < 2; ++n) v[bj][n] = v[bj][n] * qscale;
                }
#pragma unroll
                for (int bj = 0; bj < 2; ++bj) {
                    u32x4 w; w.x = cvt_pk_bf16(v[bj][0][0], v[bj][0][1]); w.y = cvt_pk_bf16(v[bj][0][2], v[bj][0][3]); w.z = cvt_pk_bf16(v[bj][1][0], v[bj][1][1]); w.w = cvt_pk_bf16(v[bj][1][2], v[bj][1][3]);
                    *(u32x4*)(O + (size_t)row * 2304 + colbase + 32 * bj) = w;
                }
                asm volatile("" ::: "memory");
            }
    }
};
template <class Epi, class Sched, bool ALIGN_EPI = false, bool SP2 = false>
__device__ __forceinline__ void gemm_phase(PG8_LAS unsigned char* lds, const Gemm g, const Sched& S, const Epi& E) {
    const int tid = threadIdx.x, wid = __builtin_amdgcn_readfirstlane(tid >> 6), lane = tid & 63, wr = wid >> 2, wc = wid & 3, fr = lane & 15, fq = lane >> 4;
    const int K = g.K, nt = K / BK;
    unsigned voffA[2], voffB[2];
#pragma unroll
    for (int i = 0; i < 2; ++i) { int R, C; stage_rc(tid * 16 + i * 8192, R, C); const int Rb = Epi::PERM ? ((R & ~31) + perm32(R & 31)) : R;
        voffA[i] = (unsigned)(R * K + C) * 2u; voffB[i] = (unsigned)(Rb * K + C) * 2u; }
    const size_t kstep = (size_t)(BK * 2);
    const size_t hstep = (size_t)HALF * K * 2;
    const size_t tstep = 2 * hstep;
    const unsigned ldsw = (unsigned)wid * 1024u;
    const int aoff = lds_byte(wr * 64 + fr, fq * 8), boff = lds_byte(wc * 32 + fr, fq * 8);
#define PG8_SA(b, h) (((b) * 2 + (h)) * HTB)
#define PG8_SB(b, h) ((4 + (b) * 2 + (h)) * HTB)
#define PG8_STAGE(bufoff, gbase, voff) do { _Pragma("unroll") for (int _i = 0; _i < 2; ++_i) \
        __builtin_amdgcn_global_load_lds((const unsigned*)((const char*)(gbase) + (voff)[_i]), (PG8_LAS unsigned*)(lds + (bufoff) + ldsw + _i * 8192), 16, 0, 0); } while (0)
#define PG8_LDA(dst, b, h) do { _Pragma("unroll") for (int m = 0; m < 4; ++m) _Pragma("unroll") for (int k = 0; k < 2; ++k) dst[m][k] = *(const PG8_LAS bf16x8*)(lds + PG8_SA(b, h) + aoff + m * 2048 + k * 1024); } while (0)
#define PG8_LDB(dst, b, h) do { _Pragma("unroll") for (int n = 0; n < 2; ++n) _Pragma("unroll") for (int k = 0; k < 2; ++k) dst[n][k] = *(const PG8_LAS bf16x8*)(lds + PG8_SB(b, h) + boff + n * 2048 + k * 1024); } while (0)
#define PG8_MMA(ai, bj, At, Bt) do { __builtin_amdgcn_s_setprio(1); _Pragma("unroll") for (int m = 0; m < 4; ++m) _Pragma("unroll") for (int n = 0; n < 2; ++n) _Pragma("unroll") for (int k = 0; k < 2; ++k) \
        acc[ai][bj][m][n] = __builtin_amdgcn_mfma_f32_16x16x32_bf16(Bt[n][k], At[m][k], acc[ai][bj][m][n], 0, 0, 0); __builtin_amdgcn_s_setprio(0); } while (0)
#define PG8_WAIT_V(n) asm volatile("s_waitcnt vmcnt(" #n ")" ::: "memory")
#define PG8_WAIT_L(n) asm volatile("s_waitcnt lgkmcnt(" #n ")" ::: "memory")
#define PG8_BAR __builtin_amdgcn_s_barrier()
#define PG8_SCHED __builtin_amdgcn_sched_barrier(0)
    Unit cur, nxt; int ui = 0;
    if (!S.next(0, cur)) return;
    f32x4 acc[2][2][4][2];
#pragma unroll
    for (int a = 0; a < 2; ++a)
#pragma unroll
        for (int b = 0; b < 2; ++b)
#pragma unroll
            for (int m = 0; m < 4; ++m)
#pragma unroll
                for (int n = 0; n < 2; ++n) acc[a][b][m][n] = (f32x4){0.f, 0.f, 0.f, 0.f};
    bf16x8 At[4][2], B0[2][2], B1[2][2];
    const char* cA = (const char*)g.A + (size_t)cur.pm * tstep; const char* cB = (const char*)g.Bt + (size_t)cur.pn * tstep;
    S.a_ready(cur);
    if constexpr (SP2) {
        PG8_STAGE(PG8_SB(0, 0), cB, voffB); PG8_STAGE(PG8_SB(0, 1), cB + hstep, voffB); PG8_STAGE(PG8_SA(0, 0), cA, voffA); PG8_STAGE(PG8_SA(0, 1), cA + hstep, voffA);
        if (wr == 1) PG8_BAR;
        PG8_WAIT_V(2); PG8_BAR;
        PG8_STAGE(PG8_SB(1, 0), cB + kstep, voffB); PG8_STAGE(PG8_SA(1, 0), cA + kstep, voffA); PG8_STAGE(PG8_SB(1, 1), cB + hstep + kstep, voffB);
        PG8_WAIT_V(6); PG8_BAR;
    } else {
        PG8_STAGE(PG8_SB(0, 0), cB, voffB); PG8_STAGE(PG8_SA(0, 0), cA, voffA); PG8_STAGE(PG8_SB(0, 1), cB + hstep, voffB); PG8_STAGE(PG8_SA(0, 1), cA + hstep, voffA);
        if (wr == 1) PG8_BAR;
        PG8_WAIT_V(4); PG8_BAR;
        PG8_STAGE(PG8_SB(1, 0), cB + kstep, voffB); PG8_STAGE(PG8_SA(1, 0), cA + kstep, voffA); PG8_STAGE(PG8_SB(1, 1), cB + hstep + kstep, voffB);
        PG8_WAIT_V(6); PG8_BAR;
    }
    for (;;) {
        const bool has_next = S.next(ui + 1, nxt);
        const char* nA = has_next ? (const char*)g.A + (size_t)nxt.pm * tstep : cA; const char* nB = has_next ? (const char*)g.Bt + (size_t)nxt.pn * tstep : cB;
        for (int t = 0; t < nt; t += 2) {
            const bool last = (t == nt - 2);
            const char* a1 = cA + (size_t)(t + 1) * kstep;
            const char* a2 = last ? nA : cA + (size_t)(t + 2) * kstep; const char* b2 = last ? nB : cB + (size_t)(t + 2) * kstep;
            const char* a3 = a2 + kstep; const char* b3 = b2 + kstep;
            if (last && has_next) S.a_ready(nxt);
            if constexpr (SP2) {
            PG8_LDB(B0, 0, 0); PG8_LDB(B1, 0, 1); PG8_SCHED; PG8_LDA(At, 0, 0); PG8_STAGE(PG8_SA(1, 1), a1 + hstep, voffA);
            PG8_WAIT_V(8); PG8_WAIT_L(0); PG8_BAR; PG8_MMA(0, 0, At, B0); PG8_MMA(0, 1, At, B1); PG8_BAR; PG8_SCHED;
            PG8_LDA(At, 0, 1); PG8_STAGE(PG8_SB(0, 0), b2, voffB); PG8_STAGE(PG8_SB(0, 1), b2 + hstep, voffB); PG8_STAGE(PG8_SA(0, 0), a2, voffA);
            PG8_WAIT_V(8); PG8_WAIT_L(0); PG8_BAR; PG8_MMA(1, 0, At, B0); PG8_MMA(1, 1, At, B1); PG8_BAR; PG8_SCHED;
            PG8_LDB(B0, 1, 0); PG8_LDB(B1, 1, 1); PG8_SCHED; PG8_LDA(At, 1, 0); PG8_STAGE(PG8_SA(0, 1), a2 + hstep, voffA);
            PG8_WAIT_V(8); PG8_WAIT_L(0); PG8_BAR; PG8_MMA(0, 0, At, B0); PG8_MMA(0, 1, At, B1); PG8_BAR; PG8_SCHED;
            PG8_LDA(At, 1, 1); PG8_STAGE(PG8_SB(1, 0), b3, voffB); PG8_STAGE(PG8_SB(1, 1), b3 + hstep, voffB); PG8_STAGE(PG8_SA(1, 0), a3, voffA);
            PG8_WAIT_V(8); PG8_WAIT_L(0); PG8_BAR; PG8_MMA(1, 0, At, B0); PG8_MMA(1, 1, At, B1); PG8_BAR; PG8_SCHED;
            } else {
            PG8_LDB(B0, 0, 0); PG8_SCHED; PG8_LDA(At, 0, 0); PG8_STAGE(PG8_SA(1, 1), a1 + hstep, voffA);
            PG8_WAIT_L(8); PG8_BAR; PG8_WAIT_L(0); PG8_MMA(0, 0, At, B0); PG8_BAR; PG8_SCHED;
            PG8_LDB(B1, 0, 1); PG8_STAGE(PG8_SB(0, 0), b2, voffB);
            PG8_BAR; PG8_WAIT_L(0); PG8_MMA(0, 1, At, B1); PG8_BAR;
            PG8_LDA(At, 0, 1); PG8_STAGE(PG8_SA(0, 0), a2, voffA);
            PG8_BAR; PG8_WAIT_L(0); PG8_MMA(1, 0, At, B0); PG8_BAR; PG8_SCHED;
            PG8_STAGE(PG8_SB(0, 1), b2 + hstep, voffB);
            PG8_WAIT_V(6); PG8_BAR; PG8_MMA(1, 1, At, B1); PG8_BAR;
            PG8_LDB(B0, 1, 0); PG8_SCHED; PG8_LDA(At, 1, 0); PG8_STAGE(PG8_SA(0, 1), a2 + hstep, voffA);
            PG8_WAIT_L(8); PG8_BAR; PG8_WAIT_L(0); PG8_MMA(0, 0, At, B0); PG8_BAR; PG8_SCHED;
            PG8_LDB(B1, 1, 1); PG8_STAGE(PG8_SB(1, 0), b3, voffB);
            PG8_BAR; PG8_WAIT_L(0); PG8_MMA(0, 1, At, B1); PG8_BAR;
            PG8_LDA(At, 1, 1); PG8_STAGE(PG8_SA(1, 0), a3, voffA);
            PG8_BAR; PG8_WAIT_L(0); PG8_MMA(1, 0, At, B0); PG8_BAR; PG8_SCHED;
            PG8_STAGE(PG8_SB(1, 1), b3 + hstep, voffB);
            PG8_WAIT_V(6); PG8_BAR; PG8_MMA(1, 1, At, B1); PG8_BAR;
            }
        }
        if constexpr (ALIGN_EPI) { if (wr == 0) PG8_BAR; }
        if constexpr (!Epi::AFTER_DRAIN) { E(acc, cur, wr, wc, fr, fq); S.done(cur); }
        if (!has_next) break;
#pragma unroll
        for (int a = 0; a < 2; ++a)
#pragma unroll
            for (int b = 0; b < 2; ++b)
#pragma unroll
                for (int m = 0; m < 4; ++m)
#pragma unroll
                    for (int n = 0; n < 2; ++n) acc[a][b][m][n] = (f32x4){0.f, 0.f, 0.f, 0.f};
        cur = nxt; cA = nA; cB = nB; ++ui;
        if constexpr (ALIGN_EPI) { if (wr == 1) PG8_BAR; }
    }
    PG8_WAIT_V(0);
    if constexpr (!ALIGN_EPI) { if (wr == 0) PG8_BAR; }
    PG8_BAR;
    if constexpr (Epi::AFTER_DRAIN) { E.fused(acc, cur, wr, wc, fr, fq, lds, wid, lane); S.done(cur); }
#undef PG8_SA
#undef PG8_SB
#undef PG8_STAGE
#undef PG8_LDA
#undef PG8_LDB
#undef PG8_MMA
#undef PG8_WAIT_V
#undef PG8_WAIT_L
#undef PG8_BAR
#undef PG8_SCHED
}
}
namespace att {
using bf16 = unsigned short;
using bf16x8 = __attribute__((ext_vector_type(8))) short;
using s16x4 = __attribute__((ext_vector_type(4))) short;
using f32x16 = __attribute__((ext_vector_type(16))) float;
using u32x4 = __attribute__((ext_vector_type(4))) unsigned;
using f32x4 = __attribute__((ext_vector_type(4))) float;
constexpr int SEQ = 4096, PITCH = 2304, KVBLK = 64, NT = SEQ / KVBLK, NW = 8;
constexpr int NSLOT = 3, SLOTB = 8192;
constexpr int LDS_K = 0, LDS_V = NSLOT * SLOTB, LDS_WS = 2 * NSLOT * SLOTB, LDS_TBL = LDS_WS + NW * 256, LDS_OST = LDS_TBL + 2048, LDS_BYTES = LDS_OST + NW * 8192;
constexpr int TBL_N = 384, TBL_OFF = 192;
__device__ __forceinline__ int crow(int r, int hi) { return (r & 3) + 8 * (r >> 2) + 4 * hi; }
#define ATT_SBAR() __builtin_amdgcn_sched_barrier(0)
__device__ __forceinline__ void glds16(const void* gsrc, unsigned lds_dst) { unsigned keep;
  asm volatile("s_mov_b32 %0, m0\n\ts_mov_b32 m0, %2\n\ts_nop 0\n\tglobal_load_lds_dwordx4 %1, off\n\ts_mov_b32 m0, %0" : "=&s"(keep) : "v"(gsrc), "s"(lds_dst) : "memory"); }
typedef float f32x2_t __attribute__((ext_vector_type(2))); typedef __bf16 bf16x2_t __attribute__((ext_vector_type(2)));
__device__ __forceinline__ unsigned cvtpk_s(float lo, float hi) { f32x2_t v = {lo, hi}; bf16x2_t b = __builtin_convertvector(v, bf16x2_t); return __builtin_bit_cast(unsigned, b); }
__device__ __forceinline__ void pv(f32x16* o, int vb, bf16x8 pa0, bf16x8 pa1, bf16x8 pa2, bf16x8 pa3) {
  #pragma unroll
  for (int d0 = 0; d0 < 2; ++d0) { s16x4 lo[4], hi[4];
    #pragma unroll
    for (int ks = 0; ks < 4; ++ks) {
      asm volatile("ds_read_b64_tr_b16 %0,%1 offset:%c2" : "=&v"(lo[ks]) : "v"(vb), "i"(d0 * 4096 + ks * 1024) : "memory");
      asm volatile("ds_read_b64_tr_b16 %0,%1 offset:%c2" : "=&v"(hi[ks]) : "v"(vb), "i"(d0 * 4096 + ks * 1024 + 512) : "memory"); }
    asm volatile("s_waitcnt lgkmcnt(0)" ::: "memory"); ATT_SBAR();
    #define ATT_PK(k) (bf16x8){lo[k][0], lo[k][1], lo[k][2], lo[k][3], hi[k][0], hi[k][1], hi[k][2], hi[k][3]}
    o[d0] = __builtin_amdgcn_mfma_f32_32x32x16_bf16(pa0, ATT_PK(0), o[d0], 0, 0, 0);
    o[d0] = __builtin_amdgcn_mfma_f32_32x32x16_bf16(pa1, ATT_PK(1), o[d0], 0, 0, 0);
    o[d0] = __builtin_amdgcn_mfma_f32_32x32x16_bf16(pa2, ATT_PK(2), o[d0], 0, 0, 0);
    o[d0] = __builtin_amdgcn_mfma_f32_32x32x16_bf16(pa3, ATT_PK(3), o[d0], 0, 0, 0);
    #undef ATT_PK
  }
}
typedef __attribute__((address_space(3))) const char* lds_cptr;
typedef __attribute__((address_space(3))) float* lds_fptr;

template <bool MODEA>
__device__ __forceinline__ void attn_unit_simple(int b, int h, int qb, const bf16* QKV, bf16* AO, char* shm, const float* bias_tab, float lam, const float* subln) {
  const int tid = threadIdx.x, lane = tid & 63, r32 = lane & 31, hi = lane >> 5; const int wid = __builtin_amdgcn_readfirstlane(tid >> 6);
  const int part = MODEA ? (wid >> 2) : 0, w4 = MODEA ? (wid & 3) : wid;
  const int q0 = MODEA ? qb * 128 : qb * 256, qw0 = q0 + 32 * w4;
  const long rowbase = (long)b * SEQ;
  const int qcol = MODEA ? h * 64 + 32 * part : 1536 + h * 64;
  const int kcol = MODEA ? 512 + h * 64 : 2048 + (h >> 2) * 64;
  const int vcol = MODEA ? 1024 + h * 64 : 2176 + (h >> 2) * 64;
  constexpr int NDK = MODEA ? 2 : 4;
  const bf16* Qw = QKV + (rowbase + qw0) * PITCH + qcol;
  const bf16* Kh = QKV + rowbase * PITCH + kcol; const bf16* Vh = QKV + rowbase * PITCH + vcol;
  const unsigned lds0 = (unsigned)(uintptr_t)shm;
  const lds_cptr shm3 = (lds_cptr)shm;
  lds_fptr wsf = (lds_fptr)(shm3 + LDS_WS) + wid * 64;
  lds_fptr tbl = (lds_fptr)(shm3 + LDS_TBL);
  const bf16* ksrc = Kh + (long)lane * PITCH + wid * 8;
  const bf16* vsrc = Vh + (long)(16 * (wid & 3) + (lane >> 2)) * PITCH + (wid >> 2) * 32 + (lane & 3) * 8;
  const unsigned kdst = lds0 + LDS_K + wid * 1024, vdst = lds0 + LDS_V + wid * 1024;
  const int vb0 = (int)(lds0 + LDS_V) + ((lane >> 4) & 1) * 32 + (lane & 3) * 8 + (4 * hi + ((lane & 15) >> 2)) * 64;
  const lds_cptr kp0 = shm3 + LDS_K + part * 4096 + hi * 1024 + r32 * 16;
  if (MODEA) { if (tid < TBL_N) tbl[tid] = bias_tab[h * TBL_N + tid]; }
  bf16x8 qr[NDK];
  #pragma unroll
  for (int d0 = 0; d0 < NDK; ++d0) qr[d0] = *reinterpret_cast<const bf16x8*>(&Qw[(long)r32 * PITCH + d0 * 16 + hi * 8]);
  float m_run = -1e30f, l_reg = 0.f; f32x16 o[2]; o[0] = f32x16{}; o[1] = f32x16{};
  float cL = 0.f, cR = 0.f;
  for (int t = 0; t < NT; ++t) {
    asm volatile("s_waitcnt lgkmcnt(0)\n\ts_barrier" ::: "memory");
    glds16(ksrc + (long)t * KVBLK * PITCH, (unsigned)__builtin_amdgcn_readfirstlane(kdst));
    glds16(vsrc + (long)t * KVBLK * PITCH, (unsigned)__builtin_amdgcn_readfirstlane(vdst));
    asm volatile("s_waitcnt vmcnt(0)\n\ts_barrier" ::: "memory");
    if (MODEA && t == 0) { cL = tbl[0]; cR = tbl[TBL_N - 1]; }
    f32x16 p0, p1;
    #pragma unroll
    for (int d0 = 0; d0 < NDK; ++d0) {
      const bf16x8 b0 = *(const __attribute__((address_space(3))) bf16x8*)(kp0 + d0 * 2048);
      const bf16x8 b1 = *(const __attribute__((address_space(3))) bf16x8*)(kp0 + d0 * 2048 + 512);
      if (d0 == 0) { p0 = __builtin_amdgcn_mfma_f32_32x32x16_bf16(b0, qr[0], f32x16{}, 0, 0, 0); p1 = __builtin_amdgcn_mfma_f32_32x32x16_bf16(b1, qr[0], f32x16{}, 0, 0, 0); }
      else { p0 = __builtin_amdgcn_mfma_f32_32x32x16_bf16(b0, qr[d0], p0, 0, 0, 0); p1 = __builtin_amdgcn_mfma_f32_32x32x16_bf16(b1, qr[d0], p1, 0, 0, 0); }
    }
    if (MODEA) {
      const int kt = t * KVBLK;
      if (kt + 63 - qw0 <= -91) {
        #pragma unroll
        for (int r = 0; r < 16; ++r) { p0[r] += cL; p1[r] += cL; }
      } else if (kt - (qw0 + 31) >= 91) {
        #pragma unroll
        for (int r = 0; r < 16; ++r) { p0[r] += cR; p1[r] += cR; }
      } else {
        const lds_fptr tb = tbl + (kt - (qw0 + r32) + TBL_OFF + 4 * hi);
        #pragma unroll
        for (int r = 0; r < 16; ++r) { p0[r] += tb[(r & 3) + 8 * (r >> 2)]; p1[r] += tb[32 + (r & 3) + 8 * (r >> 2)]; }
      }
    }
    float rm = fmaxf(p0[0], p1[0]);
    #pragma unroll
    for (int r = 1; r < 16; ++r) rm = fmaxf(rm, fmaxf(p0[r], p1[r]));
    { auto rr = __builtin_amdgcn_permlane32_swap(__float_as_uint(rm), __float_as_uint(rm), false, false); rm = fmaxf(__uint_as_float(rr[0]), __uint_as_float(rr[1])); }
    const float mnew = fmaxf(m_run, rm);
    if (__any(mnew > m_run)) {
      const float alpha = __builtin_amdgcn_exp2f(m_run - mnew);
      l_reg *= alpha; m_run = mnew;
      if (hi == 0) wsf[r32] = alpha;
      asm volatile("s_waitcnt lgkmcnt(0)" ::: "memory");
      #pragma unroll
      for (int d = 0; d < 2; ++d)
        #pragma unroll
        for (int r = 0; r < 16; ++r) o[d][r] *= wsf[crow(r, hi)];
    }
    float sacc = 0.f;
    #pragma unroll
    for (int r = 0; r < 16; ++r) { p0[r] = __builtin_amdgcn_exp2f(p0[r] - m_run); p1[r] = __builtin_amdgcn_exp2f(p1[r] - m_run); sacc += p0[r] + p1[r]; }
    l_reg += sacc;
    u32x4 pw0, pw1, pw2, pw3;
    pw0 = (u32x4){cvtpk_s(p0[0], p0[1]), cvtpk_s(p0[2], p0[3]), cvtpk_s(p0[4], p0[5]), cvtpk_s(p0[6], p0[7])};
    pw1 = (u32x4){cvtpk_s(p0[8], p0[9]), cvtpk_s(p0[10], p0[11]), cvtpk_s(p0[12], p0[13]), cvtpk_s(p0[14], p0[15])};
    pw2 = (u32x4){cvtpk_s(p1[0], p1[1]), cvtpk_s(p1[2], p1[3]), cvtpk_s(p1[4], p1[5]), cvtpk_s(p1[6], p1[7])};
    pw3 = (u32x4){cvtpk_s(p1[8], p1[9]), cvtpk_s(p1[10], p1[11]), cvtpk_s(p1[12], p1[13]), cvtpk_s(p1[14], p1[15])};
    ATT_SBAR();
    pv(o, vb0, __builtin_bit_cast(bf16x8, pw0), __builtin_bit_cast(bf16x8, pw1), __builtin_bit_cast(bf16x8, pw2), __builtin_bit_cast(bf16x8, pw3));
  }
  { auto rr = __builtin_amdgcn_permlane32_swap(__float_as_uint(l_reg), __float_as_uint(l_reg), false, false); l_reg = __uint_as_float(rr[0]) + __uint_as_float(rr[1]); }
  if (hi == 0) wsf[32 + r32] = l_reg;
  asm volatile("s_waitcnt lgkmcnt(0)" ::: "memory");
  float rli[16];
  #pragma unroll
  for (int r = 0; r < 16; ++r) rli[r] = __builtin_amdgcn_rcpf(wsf[32 + crow(r, hi)]);
  if (!MODEA) {
    bf16* Ow = AO + (rowbase + qw0) * 1024 + 512 + h * 64;
    __attribute__((address_space(3))) bf16* stg = (__attribute__((address_space(3))) bf16*)(shm3 + LDS_OST) + wid * 4096;
    #pragma unroll
    for (int r = 0; r < 16; ++r) { const int orow = crow(r, hi);
      #pragma unroll
      for (int d0 = 0; d0 < 2; ++d0) stg[orow * 64 + d0 * 32 + r32] = (bf16)(cvtpk_s(o[d0][r] * rli[r], 0.f) & 0xffffu); }
    asm volatile("s_waitcnt lgkmcnt(0)" ::: "memory");
    #pragma unroll
    for (int i = 0; i < 4; ++i) { const int row = i * 8 + (lane >> 3), ch = lane & 7; const u32x4 v = *(const __attribute__((address_space(3))) u32x4*)(stg + row * 64 + ch * 8); *(u32x4*)(Ow + (long)row * 1024 + ch * 8) = v; }
  } else {
    lds_fptr stg = (lds_fptr)(shm3 + LDS_OST) + wid * 2048;
    #pragma unroll
    for (int r = 0; r < 16; ++r) { const int orow = crow(r, hi);
      #pragma unroll
      for (int d0 = 0; d0 < 2; ++d0) stg[orow * 64 + d0 * 32 + r32] = o[d0][r] * rli[r]; }
    asm volatile("s_waitcnt lgkmcnt(0)\n\ts_barrier" ::: "memory");
    const lds_fptr s1 = (lds_fptr)(shm3 + LDS_OST) + w4 * 2048, s2 = s1 + 4 * 2048;
    bf16* Ow = AO + (rowbase + q0 + 32 * w4) * 1024 + h * 64;
    #pragma unroll
    for (int i = 0; i < 2; ++i) {
      const int row = 16 * part + i * 8 + (lane >> 3), ch = lane & 7;
      const f32x4 a0 = *(const __attribute__((address_space(3))) f32x4*)(s1 + row * 64 + ch * 8), a1 = *(const __attribute__((address_space(3))) f32x4*)(s1 + row * 64 + ch * 8 + 4);
      const f32x4 b0 = *(const __attribute__((address_space(3))) f32x4*)(s2 + row * 64 + ch * 8), b1 = *(const __attribute__((address_space(3))) f32x4*)(s2 + row * 64 + ch * 8 + 4);
      const f32x4 d0v = a0 - b0 * lam, d1v = a1 - b1 * lam;
      float q = ((d0v[0] * d0v[0] + d0v[1] * d0v[1]) + (d0v[2] * d0v[2] + d0v[3] * d0v[3])) + ((d1v[0] * d1v[0] + d1v[1] * d1v[1]) + (d1v[2] * d1v[2] + d1v[3] * d1v[3]));
      q += __shfl_xor(q, 1); q += __shfl_xor(q, 2); q += __shfl_xor(q, 4);
      const float rs = rsqrtf(q * (1.0f / 64.0f) + 1e-6f) * 0.8f;
      const f32x4 g0 = *(const f32x4*)(subln + ch * 8), g1 = *(const f32x4*)(subln + ch * 8 + 4);
      const f32x4 y0 = d0v * rs * g0, y1 = d1v * rs * g1;
      u32x4 w; w.x = cvtpk_s(y0[0], y0[1]); w.y = cvtpk_s(y0[2], y0[3]); w.z = cvtpk_s(y1[0], y1[1]); w.w = cvtpk_s(y1[2], y1[3]);
      *(u32x4*)(Ow + (long)row * 1024 + ch * 8) = w;
    }
  }
  asm volatile("s_waitcnt lgkmcnt(0)\n\ts_barrier" ::: "memory");
}

__device__ __forceinline__ float max3f(float a, float b, float c) { float r; asm("v_max3_f32 %0, %1, %2, %3" : "=v"(r) : "v"(a), "v"(b), "v"(c)); return r; }
__device__ __forceinline__ float max2f(float a, float b) { float r; asm("v_max_f32_e32 %0, %1, %2" : "=v"(r) : "v"(a), "v"(b)); return r; }
__device__ __forceinline__ float fadd_s(float a, float b) { float r; asm("v_add_f32_e32 %0, %1, %2" : "=v"(r) : "v"(a), "v"(b)); return r; }
__device__ __forceinline__ float fsub_s(float a, float b) { float r; asm("v_sub_f32_e32 %0, %1, %2" : "=v"(r) : "v"(a), "v"(b)); return r; }
#define ATT_WAIT_BAR(N) asm volatile("s_waitcnt vmcnt(" #N ") lgkmcnt(0)\n\ts_barrier" ::: "memory")
typedef short v4i16_t __attribute__((ext_vector_type(4)));
__device__ __forceinline__ void kload2(bf16x8* kf, lds_cptr kp, int j) { kf[2 * j] = *(const __attribute__((address_space(3))) bf16x8*)(kp + j * 2048); kf[2 * j + 1] = *(const __attribute__((address_space(3))) bf16x8*)(kp + j * 2048 + 512); }
__device__ __forceinline__ s16x4 vtr(lds_cptr p) { return __builtin_bit_cast(s16x4, __builtin_amdgcn_ds_read_tr16_b64_v4i16((__attribute__((address_space(3))) v4i16_t*)p)); }
__device__ __forceinline__ float rowmax(const f32x16& p0, const f32x16& p1) {
  float a = max3f(p0[0], p0[1], p1[0]), b = max3f(p0[2], p0[3], p1[1]); a = max3f(a, p1[2], p1[3]);
  #pragma unroll
  for (int r = 4; r < 16; r += 4) { a = max3f(a, p0[r], p0[r + 1]); b = max3f(b, p0[r + 2], p0[r + 3]); a = max3f(a, p1[r], p1[r + 1]); b = max3f(b, p1[r + 2], p1[r + 3]); }
  const float m = max2f(a, b);
  auto rr = __builtin_amdgcn_permlane32_swap(__float_as_uint(m), __float_as_uint(m), false, false);
  return max2f(__uint_as_float(rr[0]), __uint_as_float(rr[1]));
}
#define ATT_MFMA(a, b, c) __builtin_amdgcn_mfma_f32_32x32x16_bf16(a, b, c, 0, 0, 0)

template <bool MODEA, int THRL>
__device__ __forceinline__ void attn_unit(int b, int h, int qb, const bf16* QKV, bf16* AO, char* shm, const float* bias_tab, float lam, const float* subln) {
  const int tid = threadIdx.x, lane = tid & 63, r32 = lane & 31, hi = lane >> 5; const int wid = __builtin_amdgcn_readfirstlane(tid >> 6);
  const int part = MODEA ? (wid >> 2) : 0, w4 = MODEA ? (wid & 3) : wid;
  const int q0 = MODEA ? qb * 128 : qb * 256, qw0 = q0 + 32 * w4;
  const long rowbase = (long)b * SEQ;
  const int qcol = MODEA ? h * 64 + 32 * part : 1536 + h * 64;
  const int kcol = MODEA ? 512 + h * 64 : 2048 + (h >> 2) * 64;
  const int vcol = MODEA ? 1024 + h * 64 : 2176 + (h >> 2) * 64;
  constexpr int NDK = MODEA ? 2 : 4;
  const bf16* Qw = QKV + (rowbase + qw0) * PITCH + qcol;
  const bf16* Kh = QKV + rowbase * PITCH + kcol; const bf16* Vh = QKV + rowbase * PITCH + vcol;
  const unsigned lds0 = (unsigned)(uintptr_t)shm;
  const lds_cptr shm3 = (lds_cptr)shm;
  lds_fptr wsf = (lds_fptr)(shm3 + LDS_WS) + wid * 64;
  lds_fptr tbl = (lds_fptr)(shm3 + LDS_TBL);
  const bf16* ksrc = Kh + (long)lane * PITCH + wid * 8;
  const bf16* vsrc = Vh + (long)(16 * (wid & 3) + (lane >> 2)) * PITCH + (wid >> 2) * 32 + (lane & 3) * 8;
  const unsigned kdst = lds0 + LDS_K + wid * 1024, vdst = lds0 + LDS_V + wid * 1024;
  #define DMA_K(t, slot) glds16(ksrc + (long)(t) * KVBLK * PITCH, (unsigned)__builtin_amdgcn_readfirstlane(kdst + (slot)))
  #define DMA_V(t, slot) glds16(vsrc + (long)(t) * KVBLK * PITCH, (unsigned)__builtin_amdgcn_readfirstlane(vdst + (slot)))
  const int vb0 = (int)(lds0 + LDS_V) + ((lane >> 4) & 1) * 32 + (lane & 3) * 8 + (4 * hi + ((lane & 15) >> 2)) * 64;
  bf16x8 kf[2 * NDK];
  const lds_cptr kp0 = shm3 + LDS_K + part * 4096 + hi * 1024 + r32 * 16;
  const lds_cptr vp0 = shm3 + LDS_V + ((lane >> 4) & 1) * 32 + (lane & 3) * 8 + (4 * hi + ((lane & 15) >> 2)) * 64;
  int tL = 0, tR = NT; float cL = 0.f, cR = 0.f, creg = 0.f;
  if (MODEA) { if (tid < TBL_N) tbl[tid] = bias_tab[h * TBL_N + tid]; cL = bias_tab[h * TBL_N]; cR = bias_tab[h * TBL_N + TBL_N - 1];
    tL = (qw0 >= 154) ? (qw0 - 154) / 64 + 1 : 0; tR = (qw0 + 122 + 63) / 64; }
  DMA_K(0, 0); DMA_V(0, 0); DMA_K(1, SLOTB);
  bf16x8 qr[NDK];
  #pragma unroll
  for (int d0 = 0; d0 < NDK; ++d0) qr[d0] = *reinterpret_cast<const bf16x8*>(&Qw[(long)r32 * PITCH + d0 * 16 + hi * 8]);
  float mhat = 0.f, l_reg = 0.f; f32x16 o[2]; o[0] = f32x16{}; o[1] = f32x16{}; f32x16 negm = f32x16{};
  if (MODEA) { creg = (0 < tL) ? cL : 0.f;
    #pragma unroll
    for (int r = 0; r < 16; ++r) negm[r] = creg; }
  asm volatile("" : "+v"(negm));
  #define BIAS(C0, C1, t) do { if (MODEA) { if ((t) >= tL && (t) < tR) { const lds_fptr tb_ = tbl + ((t) * KVBLK - (qw0 + r32) + TBL_OFF + 4 * hi); \
      _Pragma("unroll") for (int r = 0; r < 16; ++r) { C0[r] += tb_[(r & 3) + 8 * (r >> 2)]; C1[r] += tb_[32 + (r & 3) + 8 * (r >> 2)]; } } } } while (0)
  #define REGION(t) do { if (MODEA) { if ((t) == tL || (t) == tR) { const float cn_ = ((t) < tL) ? cL : (((t) >= tR) ? cR : 0.f); const float dl_ = cn_ - creg; creg = cn_; \
      _Pragma("unroll") for (int r = 0; r < 16; ++r) negm[r] += dl_; asm volatile("" : "+v"(negm)); } } } while (0)
  bool resc = false;
  #define START(P0, P1) do { const float rm = rowmax(P0, P1); resc = false; \
    { const float dl = rm; mhat = fadd_s(mhat, dl); \
      _Pragma("unroll") for (int r = 0; r < 16; ++r) { P0[r] = fsub_s(P0[r], dl); P1[r] = fsub_s(P1[r], dl); } \
      _Pragma("unroll") for (int r = 0; r < 16; ++r) negm[r] = creg - mhat; asm volatile("" : "+v"(negm)); } \
    _Pragma("unroll") for (int r = 0; r < 16; ++r) P0[r] = __builtin_amdgcn_exp2f(P0[r]); } while (0)
  #define RESC() do { if (resc) { asm volatile("s_waitcnt lgkmcnt(0)" ::: "memory"); \
      _Pragma("unroll") for (int d_ = 0; d_ < 2; ++d_) _Pragma("unroll") for (int r = 0; r < 16; ++r) o[d_][r] *= wsf[crow(r, hi)]; } } while (0)
  f32x16 pA0, pA1, pB0, pB1;
  int sl_prev = 0, sl_cur = 0, sl_next = SLOTB;
  #define ROT() do { sl_prev = sl_cur; sl_cur = sl_next; sl_next = (sl_next == (NSLOT - 1) * SLOTB) ? 0 : sl_next + SLOTB; } while (0)
  DMA_K(2, 2 * SLOTB);
  ATT_WAIT_BAR(3);
  { const lds_cptr kb = kp0;
    #pragma unroll
    for (int d0 = 0; d0 < NDK; ++d0) {
      const bf16x8 b0 = *(const __attribute__((address_space(3))) bf16x8*)(kb + d0 * 2048);
      const bf16x8 b1 = *(const __attribute__((address_space(3))) bf16x8*)(kb + d0 * 2048 + 512);
      if (d0 == 0) { pA0 = ATT_MFMA(b0, qr[0], negm); pA1 = ATT_MFMA(b1, qr[0], negm); }
      else { pA0 = ATT_MFMA(b0, qr[d0], pA0); pA1 = ATT_MFMA(b1, qr[d0], pA1); } } }
  asm volatile("s_nop 15\n\ts_nop 7" : "+v"(pA0), "+v"(pA1));
  BIAS(pA0, pA1, 0);
  asm volatile("s_nop 1" : "+v"(pA0), "+v"(pA1));
  START(pA0, pA1);
  _Pragma("unroll") for (int r = 0; r < 16; ++r) pA1[r] = __builtin_amdgcn_exp2f(pA1[r]);
  ATT_WAIT_BAR(0);
  DMA_K(3, 0); DMA_V(1, SLOTB);
  ROT();
  #pragma unroll
  for (int j = 0; j < NDK; ++j) kload2(kf, kp0 + sl_cur, j);
  ATT_WAIT_BAR(2);
  s16x4 vlo[8], vhi[8]; u32x4 pw0, pw1, pw2, pw3;
  #define PKW(P, B) cvtpk_s(P[B], P[B + 1])
  #define PAF(k) __builtin_bit_cast(bf16x8, pw##k)
  #define VFR(i) (bf16x8){vlo[i][0], vlo[i][1], vlo[i][2], vlo[i][3], vhi[i][0], vhi[i][1], vhi[i][2], vhi[i][3]}
  #define PIN(x) asm volatile("" : "+v"(x))
  #define MX3(a, b, c) __builtin_fmaxf(__builtin_fmaxf((a), (b)), (c))
  #define QKG(g, C0, C1) do { if constexpr (NDK == 4) { if constexpr (((g) & 1) != 0) { if constexpr ((g) < 2) C1 = ATT_MFMA(kf[g], qr[(g) >> 1], negm); else C1 = ATT_MFMA(kf[g], qr[(g) >> 1], C1); } \
                                                        else { if constexpr ((g) < 2) C0 = ATT_MFMA(kf[g], qr[(g) >> 1], negm); else C0 = ATT_MFMA(kf[g], qr[(g) >> 1], C0); } } \
      else if constexpr (((g) & 1) == 0) { constexpr int i_ = (g) / 2; if constexpr ((i_ & 1) != 0) { if constexpr (i_ < 2) C1 = ATT_MFMA(kf[i_], qr[i_ >> 1], negm); else C1 = ATT_MFMA(kf[i_], qr[i_ >> 1], C1); } \
                                                        else { if constexpr (i_ < 2) C0 = ATT_MFMA(kf[i_], qr[i_ >> 1], negm); else C0 = ATT_MFMA(kf[i_], qr[i_ >> 1], C0); } } } while (0)
  #define GAPA(g, C0, C1, A0, A1, A2, A3, W0, W1, PW) do { QKG(g, C0, C1); sacc += A0; sacc += A1; sacc += A2; sacc += A3; PIN(sacc); W0; W1; PIN(PW); ATT_SBAR(); } while (0)
  #define EX(v) __builtin_amdgcn_exp2f(v)
  #define GAPB(MF, X, B) do { MF; X[B] = EX(X[B]); X[B + 1] = EX(X[B + 1]); X[B + 2] = EX(X[B + 2]); X[B + 3] = EX(X[B + 3]); PIN(X); ATT_SBAR(); } while (0)
  #define VRD(i) do { vlo[i] = vtr(vp_ + (((i) >> 2) * 4096 + ((i) & 3) * 1024)); vhi[i] = vtr(vp_ + (((i) >> 2) * 4096 + ((i) & 3) * 1024 + 512)); } while (0)
  #define KRD(G, j) do { if constexpr ((j) < NDK) { if (G) { kload2(kf, kp0 + sl_next, j); ATT_SBAR(); } } } while (0)
  #define STEP(C0, C1, P0, P1, t, GK, GV, GL) do { ATT_SBAR(); \
    REGION(t); \
    const lds_cptr vp_ = vp0 + sl_prev; \
    VRD(0); ATT_SBAR(); float sacc = (P0[0] + P0[1]); \
    GAPA(0, C0, C1, P0[2], P0[3], P0[4], P0[5],     pw0[0] = PKW(P0, 0), pw0[1] = PKW(P0, 2), pw0); \
    VRD(4); ATT_SBAR(); GAPA(1, C0, C1, P0[6], P0[7], P0[8], P0[9],     pw0[2] = PKW(P0, 4), pw0[3] = PKW(P0, 6), pw0); \
    VRD(1); ATT_SBAR(); GAPA(2, C0, C1, P0[10], P0[11], P0[12], P0[13], pw1[0] = PKW(P0, 8), pw1[1] = PKW(P0, 10), pw1); \
    VRD(5); ATT_SBAR(); GAPA(3, C0, C1, P0[14], P0[15], P1[0], P1[1],   pw1[2] = PKW(P0, 12), pw1[3] = PKW(P0, 14), pw1); \
    VRD(2); ATT_SBAR(); GAPA(4, C0, C1, P1[2], P1[3], P1[4], P1[5],     pw2[0] = PKW(P1, 0), pw2[1] = PKW(P1, 2), pw2); \
    VRD(6); ATT_SBAR(); GAPA(5, C0, C1, P1[6], P1[7], P1[8], P1[9],     pw2[2] = PKW(P1, 4), pw2[3] = PKW(P1, 6), pw2); \
    VRD(3); ATT_SBAR(); GAPA(6, C0, C1, P1[10], P1[11], P1[12], P1[13], pw3[0] = PKW(P1, 8), pw3[1] = PKW(P1, 10), pw3); \
    VRD(7); ATT_SBAR(); GAPA(7, C0, C1, P1[14], P1[15], 0.f, 0.f,       pw3[2] = PKW(P1, 12), pw3[3] = PKW(P1, 14), pw3); \
    l_reg += sacc; \
    if (GK) { DMA_K((t) + 3, sl_cur); } if (GV) { DMA_V((t) + 1, sl_next); } \
    BIAS(C0, C1, t); \
    { float a = MX3(C0[0], C0[1], C1[0]), b = MX3(C0[2], C0[3], C1[1]); a = MX3(a, C1[2], C1[3]); \
      _Pragma("unroll") for (int r = 4; r < 16; r += 4) { a = MX3(a, C0[r], C0[r + 1]); b = MX3(b, C0[r + 2], C0[r + 3]); a = MX3(a, C1[r], C1[r + 1]); b = MX3(b, C1[r + 2], C1[r + 3]); } \
      float rm = __builtin_fmaxf(a, b); { auto rr = __builtin_amdgcn_permlane32_swap(__float_as_uint(rm), __float_as_uint(rm), false, false); rm = __builtin_fmaxf(__uint_as_float(rr[0]), __uint_as_float(rr[1])); } \
      resc = false; \
      if (__builtin_expect(__any(rm > (float)THRL), 0)) { const float dl = __builtin_fmaxf(rm, 0.f); mhat += dl; \
        _Pragma("unroll") for (int r = 0; r < 16; ++r) { C0[r] -= dl; C1[r] -= dl; } \
        _Pragma("unroll") for (int r = 0; r < 16; ++r) negm[r] = creg - mhat; asm volatile("" : "+v"(negm)); \
        const float f = __builtin_amdgcn_exp2f(-dl); l_reg *= f; if (hi == 0) wsf[r32] = f; resc = true; } } \
    ATT_SBAR(); \
    GAPB(o[0] = ATT_MFMA(PAF(0), VFR(0), o[0]), C0, 0); \
    GAPB(o[1] = ATT_MFMA(PAF(0), VFR(4), o[1]), C0, 4); \
    KRD(GL, 0); GAPB(o[0] = ATT_MFMA(PAF(1), VFR(1), o[0]), C0, 8); \
    KRD(GL, 1); GAPB(o[1] = ATT_MFMA(PAF(1), VFR(5), o[1]), C0, 12); \
    KRD(GL, 2); GAPB(o[0] = ATT_MFMA(PAF(2), VFR(2), o[0]), C1, 0); \
    KRD(GL, 3); GAPB(o[1] = ATT_MFMA(PAF(2), VFR(6), o[1]), C1, 4); \
    GAPB(o[0] = ATT_MFMA(PAF(3), VFR(3), o[0]), C1, 8); \
    GAPB(o[1] = ATT_MFMA(PAF(3), VFR(7), o[1]), C1, 12); \
    } while (0)
  int t = 1;
  for (; t + 5 < NT; t += 2) {
    STEP(pB0, pB1, pA0, pA1, t, true, true, true);       ATT_WAIT_BAR(2); RESC(); ROT();
    STEP(pA0, pA1, pB0, pB1, t + 1, true, true, true);   ATT_WAIT_BAR(2); RESC(); ROT();
  }
  #define ENDW(tt) do { if ((tt) + 3 < NT) { ATT_WAIT_BAR(2); } else if ((tt) + 2 < NT) { ATT_WAIT_BAR(1); } else { ATT_WAIT_BAR(0); } } while (0)
  for (; t + 1 < NT; t += 2) {
    STEP(pB0, pB1, pA0, pA1, t, (t + 3 < NT), (t + 1 < NT), (t + 1 < NT));       ENDW(t);     RESC(); ROT();
    STEP(pA0, pA1, pB0, pB1, t + 1, (t + 4 < NT), (t + 2 < NT), (t + 2 < NT));   ENDW(t + 1); RESC(); ROT();
  }
  STEP(pB0, pB1, pA0, pA1, NT - 1, false, false, false); RESC();
  { float sacc = pB0[0] + pB0[1]; _Pragma("unroll") for (int r = 2; r < 16; ++r) sacc += pB0[r]; _Pragma("unroll") for (int r = 0; r < 16; ++r) sacc += pB1[r]; l_reg += sacc;
    pw0 = (u32x4){PKW(pB0, 0), PKW(pB0, 2), PKW(pB0, 4), PKW(pB0, 6)}; pw1 = (u32x4){PKW(pB0, 8), PKW(pB0, 10), PKW(pB0, 12), PKW(pB0, 14)};
    pw2 = (u32x4){PKW(pB1, 0), PKW(pB1, 2), PKW(pB1, 4), PKW(pB1, 6)}; pw3 = (u32x4){PKW(pB1, 8), PKW(pB1, 10), PKW(pB1, 12), PKW(pB1, 14)};
    ATT_SBAR(); pv(o, vb0 + sl_cur, PAF(0), PAF(1), PAF(2), PAF(3)); }
  #undef PKW
  #undef PAF
  #undef VFR
  #undef PIN
  #undef MX3
  #undef QKG
  #undef GAPA
  #undef GAPB
  #undef EX
  #undef VRD
  #undef KRD
  #undef STEP
  #undef ENDW
  { auto rr = __builtin_amdgcn_permlane32_swap(__float_as_uint(l_reg), __float_as_uint(l_reg), false, false); l_reg = __uint_as_float(rr[0]) + __uint_as_float(rr[1]); }
  if (hi == 0) wsf[32 + r32] = l_reg;
  asm volatile("s_waitcnt lgkmcnt(0)" ::: "memory");
  float rli[16];
  #pragma unroll
  for (int r = 0; r < 16; ++r) rli[r] = __builtin_amdgcn_rcpf(wsf[32 + crow(r, hi)]);
  if (!MODEA) {
    bf16* Ow = AO + (rowbase + qw0) * 1024 + 512 + h * 64;
    __attribute__((address_space(3))) bf16* stg = (__attribute__((address_space(3))) bf16*)(shm3 + LDS_OST) + wid * 4096;
    #pragma unroll
    for (int r = 0; r < 16; ++r) { const int orow = crow(r, hi);
      #pragma unroll
      for (int d0 = 0; d0 < 2; ++d0) stg[orow * 64 + d0 * 32 + r32] = (bf16)(cvtpk_s(o[d0][r] * rli[r], 0.f) & 0xffffu); }
    asm volatile("s_waitcnt lgkmcnt(0)" ::: "memory");
    #pragma unroll
    for (int i = 0; i < 4; ++i) { const int row = i * 8 + (lane >> 3), ch = lane & 7; const u32x4 v = *(const __attribute__((address_space(3))) u32x4*)(stg + row * 64 + ch * 8); *(u32x4*)(Ow + (long)row * 1024 + ch * 8) = v; }
  } else {
    lds_fptr stg = (lds_fptr)(shm3 + LDS_OST) + wid * 2048;
    #pragma unroll
    for (int r = 0; r < 16; ++r) { const int orow = crow(r, hi);
      #pragma unroll
      for (int d0 = 0; d0 < 2; ++d0) stg[orow * 64 + d0 * 32 + r32] = o[d0][r] * rli[r]; }
    asm volatile("s_waitcnt lgkmcnt(0)\n\ts_barrier" ::: "memory");
    const lds_fptr s1 = (lds_fptr)(shm3 + LDS_OST) + w4 * 2048, s2 = s1 + 4 * 2048;
    bf16* Ow = AO + (rowbase + q0 + 32 * w4) * 1024 + h * 64;
    #pragma unroll
    for (int i = 0; i < 2; ++i) {
      const int row = 16 * part + i * 8 + (lane >> 3), ch = lane & 7;
      const f32x4 a0 = *(const __attribute__((address_space(3))) f32x4*)(s1 + row * 64 + ch * 8), a1 = *(const __attribute__((address_space(3))) f32x4*)(s1 + row * 64 + ch * 8 + 4);
      const f32x4 b0 = *(const __attribute__((address_space(3))) f32x4*)(s2 + row * 64 + ch * 8), b1 = *(const __attribute__((address_space(3))) f32x4*)(s2 + row * 64 + ch * 8 + 4);
      const f32x4 d0v = a0 - b0 * lam, d1v = a1 - b1 * lam;
      float q = ((d0v[0] * d0v[0] + d0v[1] * d0v[1]) + (d0v[2] * d0v[2] + d0v[3] * d0v[3])) + ((d1v[0] * d1v[0] + d1v[1] * d1v[1]) + (d1v[2] * d1v[2] + d1v[3] * d1v[3]));
      q += __shfl_xor(q, 1); q += __shfl_xor(q, 2); q += __shfl_xor(q, 4);
      const float rs = rsqrtf(q * (1.0f / 64.0f) + 1e-6f) * 0.8f;
      const f32x4 g0 = *(const f32x4*)(subln + ch * 8), g1 = *(const f32x4*)(subln + ch * 8 + 4);
      const f32x4 y0 = d0v * rs * g0, y1 = d1v * rs * g1;
      u32x4 w; w.x = cvtpk_s(y0[0], y0[1]); w.y = cvtpk_s(y0[2], y0[3]); w.z = cvtpk_s(y1[0], y1[1]); w.w = cvtpk_s(y1[2], y1[3]);
      *(u32x4*)(Ow + (long)row * 1024 + ch * 8) = w;
    }
  }
  asm volatile("s_waitcnt lgkmcnt(0)\n\ts_barrier" ::: "memory");
  #undef DMA_K
  #undef DMA_V
  #undef BIAS
  #undef REGION
  #undef START
  #undef RESC
  #undef ROT
}
#undef ATT_WAIT_BAR
#undef ATT_MFMA
#undef ATT_SBAR
}
#define LAS __attribute__((address_space(3)))
#define XB_TMO      128
#define XB_XCNT(j)  (256  + 64 * (j))
#define XB_XSUB(j)  (1280 + 64 * (j))
#define XB_XGEN(j)  (2304 + 64 * (j))
#define XB_TOP      3328
#define XB_TOPGEN   3392
#define XCD_BAR_WORDS 3456
#define XB_SPIN_CAP (1u << 18)

__device__ __forceinline__ unsigned xb_ld(unsigned* p)              { return __hip_atomic_load(p, __ATOMIC_RELAXED, __HIP_MEMORY_SCOPE_AGENT); }
__device__ __forceinline__ unsigned xb_add(unsigned* p, unsigned v) { return __hip_atomic_fetch_add(p, v, __ATOMIC_RELAXED, __HIP_MEMORY_SCOPE_AGENT); }
__device__ __forceinline__ unsigned xb_xcc_id() { return (unsigned)__builtin_amdgcn_s_getreg((3 << 11) | 20) & 0xFu; }
#define XB_SPIN(cond, bar) do { unsigned _sp = 0; while (cond) { __builtin_amdgcn_s_sleep(1); \
    if ((++_sp & 255u) == 0u) { if (xb_ld(&(bar)[XB_TMO])) break; if (_sp > XB_SPIN_CAP) { atomicAdd(&(bar)[XB_TMO], 1u); break; } } } } while (0)

struct XcdBarrier {
    unsigned* bar; unsigned x;
    volatile LAS unsigned* st;
};

__device__ __forceinline__ XcdBarrier xcd_barrier_post(unsigned* bar, volatile LAS unsigned* st) {
    XcdBarrier b; b.bar = bar; b.x = xb_xcc_id(); b.st = st;
    if (threadIdx.x == 0) (void)xb_add(&bar[XB_XCNT(b.x)], 1u);
    return b;
}
__device__ __forceinline__ void xcd_barrier_complete(unsigned* bar, unsigned x, unsigned& nloc, unsigned& nx) {
    const unsigned G = gridDim.x * gridDim.y * gridDim.z;
    unsigned sum, cnt, mine, sp = 0u;
    for (;;) {
        sum = 0u; cnt = 0u; mine = 0u;
#pragma unroll
        for (unsigned j = 0; j < 16; ++j) { const unsigned c = xb_ld(&bar[XB_XCNT(j)]); sum += c; cnt += (c > 0u) ? 1u : 0u; mine = (j == x) ? c : mine; }
        if (sum == G) break;
        __builtin_amdgcn_s_sleep(1);
        if ((++sp & 255u) == 0u) { if (xb_ld(&bar[XB_TMO])) break; if (sp > XB_SPIN_CAP) { atomicAdd(&bar[XB_TMO], 1u); break; } }
    }
    nloc = mine > 0u ? mine : 1u; nx = cnt > 0u ? cnt : 1u;
}

__device__ __forceinline__ void xcd_barrier(const XcdBarrier& b) {
    asm volatile("s_waitcnt vmcnt(0)" ::: "memory");
    __syncthreads();
    if (threadIdx.x == 0) {
        unsigned* bar = b.bar;
        __builtin_amdgcn_s_waitcnt(0);
        unsigned nloc = b.st[0], nx = b.st[1];
        if (nloc == 0u) { xcd_barrier_complete(bar, b.x, nloc, nx); b.st[0] = nloc; b.st[1] = nx; }
        const unsigned old = xb_add(&bar[XB_XSUB(b.x)], 1u);
        const unsigned gen = old / nloc;
        if (old + 1u == (gen + 1u) * nloc) {
            __builtin_amdgcn_fence(__ATOMIC_RELEASE, "agent");
            asm volatile("s_waitcnt vmcnt(0)" ::: "memory");
            const unsigned og = xb_add(&bar[XB_TOP], 1u);
            const unsigned tg = og / nx;
            if (og + 1u == (tg + 1u) * nx) xb_add(&bar[XB_TOPGEN], 1u);
            else XB_SPIN(xb_ld(&bar[XB_TOPGEN]) == tg, bar);
            __builtin_amdgcn_fence(__ATOMIC_ACQUIRE, "agent");
            xb_add(&bar[XB_XGEN(b.x)], 1u);
            asm volatile("s_waitcnt vmcnt(0)" ::: "memory");
        } else {
            XB_SPIN(xb_ld(&bar[XB_XGEN(b.x)]) == gen, bar);
            __builtin_amdgcn_fence(__ATOMIC_ACQUIRE, "agent");
            asm volatile("s_waitcnt vmcnt(0)" ::: "memory");
        }
    }
    __syncthreads();
}
constexpr int NWAVES = 8;
constexpr int BATCH = 8, SEQ = 4096, D = 1024, FF = 2816, DIN = 2304, M = BATCH * SEQ;
constexpr int NPH = 9;
constexpr size_t MiB = 1u << 20;
constexpr size_t WS_CTL = 0, CTL_ZERO_BYTES = 1 * MiB;
constexpr size_t WS_TAB = 1 * MiB;
constexpr size_t TAB_CS = 256, TAB_BIAS = 256 + 8192;
constexpr size_t WS_SS1 = 2 * MiB, WS_SS2 = 4 * MiB;
constexpr size_t WS_W1GU = 8 * MiB, WS_W1D = 20 * MiB, WS_WIN = 26 * MiB, WS_WOUT = 31 * MiB, WS_W2GU = 34 * MiB, WS_W2D = 46 * MiB;
constexpr size_t WS_A = 56 * MiB;
constexpr size_t WS_B = 232 * MiB;
constexpr size_t WS_C = 296 * MiB;
constexpr size_t WS_D = 360 * MiB;
constexpr size_t WS_END = 488 * MiB;
static_assert(WS_W1GU + (size_t)2 * FF * D * 2 <= WS_W1D && WS_W1D + (size_t)FF * D * 2 <= WS_WIN && WS_WIN + (size_t)DIN * D * 2 <= WS_WOUT && WS_WOUT + (size_t)D * D * 2 <= WS_W2GU &&
              WS_W2GU + (size_t)2 * FF * D * 2 <= WS_W2D && WS_W2D + (size_t)FF * D * 2 <= WS_A && WS_A + (size_t)M * FF * 2 <= WS_B && WS_SS2 + (size_t)M * 64 <= WS_W1GU, "d_ws map");
constexpr int CW_BAR = 4096;
constexpr int RING_OFF = 0, RING_BYTES = 131072;
constexpr int LDSCTL_OFF = RING_BYTES, MISC_OFF = LDSCTL_OFF + 320;
constexpr int LDS_BYTES = 147456;
static_assert(att::LDS_BYTES <= RING_BYTES, "attention scratch fits the ring region");

#define GAS __attribute__((address_space(1)))
typedef unsigned short bf16;
typedef unsigned v4u __attribute__((ext_vector_type(4)));
typedef float f32x4 __attribute__((ext_vector_type(4)));
#define LDS_WAIT() asm volatile("s_waitcnt lgkmcnt(0)" ::: "memory")
__device__ __forceinline__ unsigned f2bf(float f) { unsigned u = __builtin_bit_cast(unsigned, f); return (u + 0x7fffu + ((u >> 16) & 1u)) >> 16; }
__device__ __forceinline__ unsigned pk2(float lo, float hi) { return f2bf(lo) | (f2bf(hi) << 16); }
__device__ __forceinline__ float wave_sum(float v) {
#pragma unroll
    for (int o = 1; o < 64; o <<= 1) v += __shfl_xor(v, o);
    return v;
}

__device__ __forceinline__ void p0_transpose_item(const float* W, int K, int N, bf16* WT, int k0, int n0, int drow0, const float* g, LAS float* scr, int lane) {
#pragma unroll 8
    for (int i = 0; i < 32; ++i) { const int kk = 2 * i + (lane >> 5); float w = W[(size_t)(k0 + kk) * N + n0 + (lane & 31)]; if (g) w *= g[k0 + kk]; scr[kk * 33 + (lane & 31)] = w; }
    LDS_WAIT(); asm volatile("" ::: "memory");
    const int c = lane & 7;
#pragma unroll
    for (int j = 0; j < 4; ++j) { const int n = (lane >> 3) + 8 * j; const LAS float* s = scr + (8 * c) * 33 + n;
        v4u o; o.x = pk2(s[0 * 33], s[1 * 33]); o.y = pk2(s[2 * 33], s[3 * 33]); o.z = pk2(s[4 * 33], s[5 * 33]); o.w = pk2(s[6 * 33], s[7 * 33]);
        *(GAS v4u*)(WT + (size_t)(drow0 + n) * K + k0 + 8 * c) = o; }
    LDS_WAIT(); asm volatile("" ::: "memory");
}

struct Args { const float* in[21]; float* out; unsigned char* ws; int ph_lo, ph_hi; };

__device__ __forceinline__ int t5_bucket(int rel) {
    const int n = rel < 0 ? -rel : rel; int bk;
    if (n < 8) bk = n; else { const int l = 2 + (31 - __clz(n * n)); bk = l < 15 ? l : 15; }
    return bk + (rel > 0 ? 16 : 0);
}

__global__ void __launch_bounds__(NWAVES * 64, 2) mega_fwd(Args args) {
    extern __shared__ __attribute__((aligned(16))) unsigned char lds[];
    LAS unsigned char* ldsp = (LAS unsigned char*)lds;
    volatile LAS unsigned* MISC = (volatile LAS unsigned*)(ldsp + MISC_OFF);
    const int tid = threadIdx.x, lane = tid & 63, wave = __builtin_amdgcn_readfirstlane(tid >> 6);
    const int G = gridDim.x; const int bx = blockIdx.x; const int vcu = (G % 8 == 0) ? (bx % 8) * (G / 8) + bx / 8 : bx;
    unsigned char* ws = args.ws;
    unsigned* ctl = (unsigned*)(ws + WS_CTL);
    const float* x = args.in[0];
    float* out = args.out;
    float* misc = (float*)(ws + WS_TAB); float* cs = misc + TAB_CS / 4; float* bias_tab = misc + TAB_BIAS / 4;
    float* ss1 = (float*)(ws + WS_SS1); float* ss2 = (float*)(ws + WS_SS2);
    bf16* W1gu = (bf16*)(ws + WS_W1GU); bf16* W1d = (bf16*)(ws + WS_W1D); bf16* WinT = (bf16*)(ws + WS_WIN); bf16* WoutT = (bf16*)(ws + WS_WOUT); bf16* W2gu = (bf16*)(ws + WS_W2GU); bf16* W2d = (bf16*)(ws + WS_W2D);
    bf16* ACT = (bf16*)(ws + WS_A); bf16* QKV = (bf16*)(ws + WS_A);
    bf16* H1 = (bf16*)(ws + WS_B); bf16* X1b = (bf16*)(ws + WS_B); bf16* AO = (bf16*)(ws + WS_B);
    bf16* X2b = (bf16*)(ws + WS_C); float* X1 = (float*)(ws + WS_D);
    for (int u = tid; u < (LDS_BYTES - LDSCTL_OFF) / 4; u += NWAVES * 64) ((LAS unsigned*)(ldsp + LDSCTL_OFF))[u] = 0u;
    __syncthreads();
    XcdBarrier bar = xcd_barrier_post(ctl + CW_BAR, MISC + 8);
    const int lo = args.ph_lo, hi = args.ph_hi;
#define IN(k) (lo <= (k) && (k) < hi)
#define SEAM(k) do { if (IN(k) && IN((k) + 1)) xcd_barrier(bar); } while (0)
    const int gw = vcu * NWAVES + wave, NGW = G * NWAVES;

    if (IN(0)) {
        LAS float* scr = (LAS float*)(ldsp + RING_OFF + wave * 16384);
        constexpr int I_GU = (D / 64) * (FF / 32), I_DN = (FF / 64) * (D / 32), I_IN = (D / 64) * (DIN / 32), I_OUT = (D / 64) * (D / 32);
        constexpr int NITEMS = 4 * I_GU + 2 * I_DN + I_IN + I_OUT;
        for (int it = gw; it < NITEMS; it += NGW) {
            int r = it;
            if (r < 4 * I_GU) {
                const int which = r / I_GU; r -= which * I_GU; const int nblk = FF / 32, kb = r / nblk, nb = r % nblk, n0 = 32 * nb;
                const float* W = args.in[which == 0 ? 2 : which == 1 ? 3 : which == 2 ? 17 : 18];
                const int drow0 = 256 * (n0 / 128) + 128 * (which & 1) + (n0 % 128);
                p0_transpose_item(W, D, FF, which < 2 ? W1gu : W2gu, 64 * kb, n0, drow0, which < 2 ? nullptr : args.in[16], scr, lane); continue; }
            r -= 4 * I_GU;
            if (r < 2 * I_DN) { const int which = r / I_DN; r -= which * I_DN; const int nblk = D / 32, kb = r / nblk, nb = r % nblk;
                p0_transpose_item(args.in[which ? 19 : 4], FF, D, which ? W2d : W1d, 64 * kb, 32 * nb, 32 * nb, nullptr, scr, lane); continue; }
            r -= 2 * I_DN;
            if (r < I_IN) { const int nblk = DIN / 32, kb = r / nblk, nb = r % nblk, n0 = 32 * nb;
                const int drow0 = 256 * (n0 / 256) + 128 * ((n0 % 64) / 32) + 32 * ((n0 % 256) / 64);
                p0_transpose_item(args.in[6], D, DIN, WinT, 64 * kb, n0, drow0, args.in[5], scr, lane); continue; }
            r -= I_IN;
            { const int nblk = D / 32, kb = r / nblk, nb = r % nblk; p0_transpose_item(args.in[15], D, D, WoutT, 64 * kb, 32 * nb, 32 * nb, nullptr, scr, lane); }
        }
        { const int gt = vcu * NWAVES * 64 + tid;
          if (gt < 1024) { const int pos = gt >> 4, f = gt & 15; const float inv = powf(10000.0f, -(float)f / 16.0f); const float ang = (float)pos * inv; cs[2 * gt] = cosf(ang); cs[2 * gt + 1] = sinf(ang); }
          else if (gt < 1024 + 8 * att::TBL_N) { const int i = gt - 1024, h = i / att::TBL_N, rel = i % att::TBL_N - att::TBL_OFF; bias_tab[i] = args.in[14][t5_bucket(rel) * 8 + h] * 1.4426950408889634f; }
          else if (gt == 1024 + 8 * att::TBL_N) { float s1 = 0.f, s2 = 0.f; for (int d = 0; d < 32; ++d) { s1 += args.in[7][d] * args.in[8][d]; s2 += args.in[9][d] * args.in[10][d]; } misc[0] = expf(s1) - expf(s2) + 0.2f; } }
        for (int m = gw; m < M; m += NGW) {
            const GAS f32x4* xr = (const GAS f32x4*)(x + (size_t)m * D) + lane; const f32x4* gr = (const f32x4*)args.in[1] + lane;
            f32x4 v[4]; float s = 0.f;
#pragma unroll
            for (int j = 0; j < 4; ++j) { v[j] = xr[64 * j]; s += (v[j].x * v[j].x + v[j].y * v[j].y) + (v[j].z * v[j].z + v[j].w * v[j].w); }
            const float rstd = rsqrtf(wave_sum(s) * (1.f / D) + 1e-6f);
            GAS unsigned long long* o8 = (GAS unsigned long long*)(H1 + (size_t)m * D) + lane;
#pragma unroll
            for (int j = 0; j < 4; ++j) { const f32x4 gg = gr[64 * j]; o8[64 * j] = (unsigned long long)pk2(v[j].x * rstd * gg.x, v[j].y * rstd * gg.y) | ((unsigned long long)pk2(v[j].z * rstd * gg.z, v[j].w * rstd * gg.w) << 32); }
        }
    }
    SEAM(0);
    if (IN(1)) { pg8::Gemm g{H1, W1gu, M, 2 * FF, D}; pg8::StaticOrder S; S.init(M, 2 * FF, G, bx); pg8::EpiSwiGLU<false> E{ACT, FF, nullptr};
        pg8::gemm_phase<pg8::EpiSwiGLU<false>, pg8::StaticOrder, true, true>(ldsp + RING_OFF, g, S, E); }
    SEAM(1);
    if (IN(2)) { pg8::Gemm g{ACT, W1d, M, D, FF}; pg8::StaticOrder S; S.init(M, D, G, bx); pg8::EpiResid<true> E{x, X1, X1b, ss1, 0.5f};
        pg8::gemm_phase<pg8::EpiResid<true>, pg8::StaticOrder, true, true>(ldsp + RING_OFF, g, S, E); }
    SEAM(2);
    if (IN(3)) { pg8::Gemm g{X1b, WinT, M, DIN, D}; pg8::StaticOrder S; S.init(M, DIN, G, bx); pg8::EpiProj E{QKV, ss1, args.in[12], args.in[13], cs};
        pg8::gemm_phase<pg8::EpiProj, pg8::StaticOrder, true, true>(ldsp + RING_OFF, g, S, E); }
    SEAM(3);
    if (IN(4)) {
        const float lam = misc[0];
        { const int NU = BATCH * 8 * 32, upc = (NU + G - 1) / G;
          for (int i = 0; i < upc; ++i) { const int u = vcu * upc + i; if (u >= NU) break; const int bh = u >> 5, qb = u & 31;
              att::attn_unit<true, 8>(bh >> 3, bh & 7, qb, QKV, AO, (char*)lds + RING_OFF, bias_tab, lam, args.in[11]); } }
        { const int NU = BATCH * 8 * 16, upc = (NU + G - 1) / G;
          for (int i = 0; i < upc; ++i) { const int u = vcu * upc + i; if (u >= NU) break; const int bh = u >> 4, qb = u & 15;
              att::attn_unit<false, 8>(bh >> 3, bh & 7, qb, QKV, AO, (char*)lds + RING_OFF, bias_tab, lam, args.in[11]); } }
    }
    SEAM(4);
    if (IN(5)) { pg8::Gemm g{AO, WoutT, M, D, D}; pg8::StaticOrder S; S.init(M, D, G, bx); pg8::EpiResid<true> E{X1, out, X2b, ss2, 1.0f};
        pg8::gemm_phase<pg8::EpiResid<true>, pg8::StaticOrder, true, true>(ldsp + RING_OFF, g, S, E); }
    SEAM(5);
    if (IN(6)) { pg8::Gemm g{X2b, W2gu, M, 2 * FF, D}; pg8::StaticOrder S; S.init(M, 2 * FF, G, bx); pg8::EpiSwiGLU<true> E{ACT, FF, ss2};
        pg8::gemm_phase<pg8::EpiSwiGLU<true>, pg8::StaticOrder, true, true>(ldsp + RING_OFF, g, S, E); }
    SEAM(6);
    if (IN(7)) { pg8::Gemm g{ACT, W2d, M, D, FF}; pg8::StaticOrder S; S.init(M, D, G, bx); pg8::EpiResid<false> E{out, out, nullptr, nullptr, 0.5f};
        pg8::gemm_phase<pg8::EpiResid<false>, pg8::StaticOrder, true, true>(ldsp + RING_OFF, g, S, E); }
    SEAM(7);
    if (IN(8)) {
        for (int m = gw; m < M; m += NGW) {
            GAS f32x4* xr = (GAS f32x4*)(out + (size_t)m * D) + lane; const f32x4* gr = (const f32x4*)args.in[20] + lane;
            f32x4 v[4]; float s = 0.f;
#pragma unroll
            for (int j = 0; j < 4; ++j) { v[j] = xr[64 * j]; s += (v[j].x * v[j].x + v[j].y * v[j].y) + (v[j].z * v[j].z + v[j].w * v[j].w); }
            const float rstd = rsqrtf(wave_sum(s) * (1.f / D) + 1e-6f);
#pragma unroll
            for (int j = 0; j < 4; ++j) { const f32x4 gg = gr[64 * j]; xr[64 * j] = v[j] * rstd * gg; }
        }
    }
#undef IN
#undef SEAM
}

extern "C" void kernel_launch(void* const* d_in, const int* in_sizes, int n_in, void* d_out, int out_size, void* d_ws, size_t ws_size, hipStream_t stream) {
    static int grid = 0;
    if (grid == 0) {
        if (n_in != 21 || in_sizes[0] != M * D || out_size != M * D || ws_size < WS_END) { fprintf(stderr, "kernel_launch: unexpected shapes (n_in %d, in0 %d, out %d, ws %zu)\n", n_in, n_in > 0 ? in_sizes[0] : -1, out_size, ws_size); grid = -1; return; }
        int dev = 0, cus = 0, per_cu = 0;
        if (hipGetDevice(&dev) != hipSuccess || hipDeviceGetAttribute(&cus, hipDeviceAttributeMultiprocessorCount, dev) != hipSuccess) { grid = -1; return; }
        if (hipFuncSetAttribute((const void*)mega_fwd, hipFuncAttributeMaxDynamicSharedMemorySize, LDS_BYTES) != hipSuccess) { fprintf(stderr, "kernel_launch: hipFuncSetAttribute failed\n"); grid = -1; return; }
        if (hipOccupancyMaxActiveBlocksPerMultiprocessor(&per_cu, (const void*)mega_fwd, NWAVES * 64, LDS_BYTES) != hipSuccess || per_cu < 1) { fprintf(stderr, "kernel_launch: occupancy query reports %d workgroups per CU\n", per_cu); (void)hipGetLastError(); grid = -1; return; }
        grid = cus;
    }
    if (grid < 0) return;
    if (hipMemsetAsync((char*)d_ws + WS_CTL, 0, CTL_ZERO_BYTES, stream) != hipSuccess) return;
    Args a{};
    for (int i = 0; i < 21; ++i) a.in[i] = (const float*)d_in[i];
    a.out = (float*)d_out; a.ws = (unsigned char*)d_ws; a.ph_lo = 0; a.ph_hi = NPH;
    hipLaunchKernelGGL(mega_fwd, dim3(grid), dim3(NWAVES * 64), LDS_BYTES, stream, a);
}
```

```cpp
#include <hip/hip_runtime.h>
#include <cstdio>
#include <cstdint>
#include <cmath>
namespace pg8 {
#define PG8_LAS __attribute__((address_space(3)))
typedef unsigned short bf16_t;
typedef short bf16x8 __attribute__((ext_vector_type(8)));
typedef float f32x4 __attribute__((ext_vector_type(4)));
typedef unsigned u32x4 __attribute__((ext_vector_type(4)));
constexpr int BM = 256, BK = 64, HALF = 128, HTB = HALF * BK * 2  , STAGE_BYTES = 8 * HTB, NXCD = 8, WGM = 8;

__host__ __device__ __forceinline__ int lds_byte(int r, int c) { const int st = (r >> 4) * 2 + (c >> 5), rr = r & 15, cc = c & 31, ob = rr * 64 + cc * 2; return st * 1024 + (ob ^ (((ob >> 9) & 1) << 5)); }
__host__ __device__ __forceinline__ void stage_rc(int b, int& R, int& C) { const int st = b / 1024, sb = b % 1024, swz = sb ^ (((sb >> 9) & 1) << 5); R = (st >> 1) * 16 + swz / 64; C = (st & 1) * 32 + (swz % 64) / 2; }
__host__ __device__ __forceinline__ int perm32(int rho) { const int n = rho >> 4, i = rho & 15; return 8 * (i >> 2) + 4 * n + (i & 3); }

struct Unit { int pm, pn; };
struct Gemm { const bf16_t* A; const bf16_t* Bt; int M, N, K; };

struct StaticOrder {
    int nM, nN, nwg, G, c;
    __host__ __device__ void init(int M, int N, int G_, int c_) { nM = M / BM; nN = N / BM; nwg = nM * nN; G = G_; c = c_; }
    __host__ __device__ bool next(int i, Unit& u) const {
        const long L = (long)i * G + c; if (L >= nwg) return false;
        int wgid = (int)L; { const int q = nwg / NXCD, r = nwg % NXCD, xcd = wgid % NXCD, off = wgid / NXCD; wgid = (xcd < r ? xcd * (q + 1) : r * (q + 1) + (xcd - r) * q) + off; }
        const int nig = WGM * nN, gid = wgid / nig, fm = gid * WGM, gsz = (nM - fm) < WGM ? (nM - fm) : WGM;
        u.pm = fm + ((wgid % nig) % gsz); u.pn = (wgid % nig) / gsz; return true;
    }
    __device__ __forceinline__ void a_ready(const Unit&) const {}
    __device__ __forceinline__ void done(const Unit&) const {}
};

__device__ __forceinline__ unsigned cvt_pk_bf16(float lo, float hi) { unsigned r; asm volatile("v_cvt_pk_bf16_f32 %0, %1, %2" : "=v"(r) : "v"(lo), "v"(hi)); return r; }
constexpr float RMS_EPS = 1e-6f;
typedef int i32x4 __attribute__((ext_vector_type(4)));
template <bool I8> __device__ __forceinline__ f32x4 pg8_mma(bf16x8 b, bf16x8 a, f32x4 c) {
    if constexpr (I8) return __builtin_bit_cast(f32x4, __builtin_amdgcn_mfma_i32_16x16x64_i8(__builtin_bit_cast(i32x4, b), __builtin_bit_cast(i32x4, a), __builtin_bit_cast(i32x4, c), 0, 0, 0));
    else return __builtin_amdgcn_mfma_f32_16x16x32_bf16(b, a, c, 0, 0, 0);
}
__device__ __forceinline__ float rstd_from_parts(const float* ss, int row) {
    const f32x4* p = (const f32x4*)(ss + (size_t)row * 16);
    const f32x4 a = p[0], b = p[1], c = p[2], d = p[3];
    const float s = (((a[0] + a[1]) + (a[2] + a[3])) + ((b[0] + b[1]) + (b[2] + b[3]))) + (((c[0] + c[1]) + (c[2] + c[3])) + ((d[0] + d[1]) + (d[2] + d[3])));
    return rsqrtf(s * (1.0f / 1024.0f) + RMS_EPS);
}
typedef float f32x2 __attribute__((ext_vector_type(2)));
__device__ __forceinline__ float rstd_from_parts_q(const float* ss, int row, int fq) {
    const f32x4 a = *(const f32x4*)(ss + (size_t)row * 16 + 4 * fq);
    float s = (a[0] + a[1]) + (a[2] + a[3]);
    s += __shfl_xor(s, 16); s += __shfl_xor(s, 32);
    return rsqrtf(s * (1.0f / 1024.0f) + RMS_EPS);
}
__device__ __forceinline__ f32x2 silu_mul2(f32x2 g, f32x2 u, float c1, float rs2) {
    const f32x2 t = g * c1; f32x2 e; e.x = __builtin_amdgcn_exp2f(t.x); e.y = __builtin_amdgcn_exp2f(t.y);
    const f32x2 d = e + 1.0f; f32x2 r; r.x = __builtin_amdgcn_rcpf(d.x); r.y = __builtin_amdgcn_rcpf(d.y);
    return (g * u) * (r * rs2);
}

template <bool RS> struct EpiSwiGLU {
    static constexpr bool PERM = true, AFTER_DRAIN = false, I8 = false;
    bf16_t* O; int ldo; const float* ss;
    __device__ __forceinline__ void operator()(const f32x4 (&acc)[2][2][4][2], const Unit& u, int wr, int wc, int fr, int fq) const {
        const int row0 = u.pm * BM + wr * 64 + fr, col0 = u.pn * HALF + wc * 32 + 8 * fq;
        float rsv[2][4];
#pragma unroll
        for (int ai = 0; ai < 2; ++ai)
#pragma unroll
            for (int m = 0; m < 4; ++m) rsv[ai][m] = RS ? rstd_from_parts_q(ss, row0 + ai * HALF + m * 16, fq) : 1.0f;
#pragma unroll
        for (int ai = 0; ai < 2; ++ai)
#pragma unroll
            for (int m = 0; m < 4; ++m) {
                const int row = row0 + ai * HALF + m * 16;
                const float rs = rsv[ai][m], c1 = -1.4426950408889634f * rs, rs2 = rs * rs;
                const f32x4 g0 = acc[ai][0][m][0], g1 = acc[ai][0][m][1], u0 = acc[ai][1][m][0], u1 = acc[ai][1][m][1];
                const f32x2 a = silu_mul2((f32x2){g0[0], g0[1]}, (f32x2){u0[0], u0[1]}, c1, rs2), b = silu_mul2((f32x2){g0[2], g0[3]}, (f32x2){u0[2], u0[3]}, c1, rs2);
                const f32x2 c = silu_mul2((f32x2){g1[0], g1[1]}, (f32x2){u1[0], u1[1]}, c1, rs2), d = silu_mul2((f32x2){g1[2], g1[3]}, (f32x2){u1[2], u1[3]}, c1, rs2);
                u32x4 w; w.x = cvt_pk_bf16(a.x, a.y); w.y = cvt_pk_bf16(b.x, b.y); w.z = cvt_pk_bf16(c.x, c.y); w.w = cvt_pk_bf16(d.x, d.y);
                *(u32x4*)(O + (size_t)row * ldo + col0) = w;
            }
    }
};

template <bool BLKO> struct EpiSwiGLU8 {
    static constexpr bool PERM = true, AFTER_DRAIN = false, I8 = true;
    bf16_t* O; int ldo; const float* Rr; const float* sb;
    __device__ __forceinline__ void operator()(const f32x4 (&acc)[2][2][4][2], const Unit& u, int wr, int wc, int fr, int fq) const {
        const int row0 = u.pm * BM + wr * 64 + fr, col0 = u.pn * HALF + wc * 32 + 8 * fq;
        const float* sbp = sb + u.pn * BM + wc * 32 + 8 * fq;
        const f32x4 sg0 = *(const f32x4*)(sbp), sg1 = *(const f32x4*)(sbp + 4), su0 = *(const f32x4*)(sbp + HALF), su1 = *(const f32x4*)(sbp + HALF + 4);
        float rv[2][4];
#pragma unroll
        for (int ai = 0; ai < 2; ++ai)
#pragma unroll
            for (int m = 0; m < 4; ++m) rv[ai][m] = Rr[row0 + ai * HALF + m * 16];
#pragma unroll
        for (int ai = 0; ai < 2; ++ai)
#pragma unroll
            for (int m = 0; m < 4; ++m) {
                const int row = row0 + ai * HALF + m * 16;
                const float R = rv[ai][m], c1 = -1.4426950408889634f * R, r2 = R * R;
                const i32x4 gi0 = __builtin_bit_cast(i32x4, acc[ai][0][m][0]), gi1 = __builtin_bit_cast(i32x4, acc[ai][0][m][1]), ui0 = __builtin_bit_cast(i32x4, acc[ai][1][m][0]), ui1 = __builtin_bit_cast(i32x4, acc[ai][1][m][1]);
                const f32x4 g0 = __builtin_convertvector(gi0, f32x4) * sg0, g1 = __builtin_convertvector(gi1, f32x4) * sg1, u0 = __builtin_convertvector(ui0, f32x4) * su0, u1 = __builtin_convertvector(ui1, f32x4) * su1;
                const f32x2 a = silu_mul2((f32x2){g0[0], g0[1]}, (f32x2){u0[0], u0[1]}, c1, r2), b = silu_mul2((f32x2){g0[2], g0[3]}, (f32x2){u0[2], u0[3]}, c1, r2);
                const f32x2 c = silu_mul2((f32x2){g1[0], g1[1]}, (f32x2){u1[0], u1[1]}, c1, r2), d = silu_mul2((f32x2){g1[2], g1[3]}, (f32x2){u1[2], u1[3]}, c1, r2);
                u32x4 w; w.x = cvt_pk_bf16(a.x, a.y); w.y = cvt_pk_bf16(b.x, b.y); w.z = cvt_pk_bf16(c.x, c.y); w.w = cvt_pk_bf16(d.x, d.y);
                if constexpr (BLKO) *(u32x4*)(O + (((size_t)u.pm * (ldo / 64) + (col0 >> 6)) * 256 + (row & 255)) * 64 + (col0 & 63)) = w;
                else *(u32x4*)(O + (size_t)row * ldo + col0) = w;
            }
    }
};

__device__ __forceinline__ f32x4 bf16lo4(unsigned a, unsigned b) { return (f32x4){__builtin_bit_cast(float, a << 16), __builtin_bit_cast(float, a & 0xffff0000u), __builtin_bit_cast(float, b << 16), __builtin_bit_cast(float, b & 0xffff0000u)}; }
template <bool AM> struct EpiResid {
    static constexpr bool PERM = true, AFTER_DRAIN = false, I8 = false;
    const bf16_t* R; bf16_t* Xb; float* ss; float alpha; float* am;
    __device__ __forceinline__ void operator()(const f32x4 (&acc)[2][2][4][2], const Unit& u, int wr, int wc, int fr, int fq) const {
        const int row0 = u.pm * BM + wr * 64 + fr, col0 = u.pn * BM + wc * 32 + 8 * fq;
        u32x4 pre[2][4][2];
#pragma unroll
        for (int ai = 0; ai < 2; ++ai)
#pragma unroll
            for (int m = 0; m < 4; ++m)
#pragma unroll
                for (int bj = 0; bj < 2; ++bj) pre[ai][m][bj] = *(const u32x4*)(R + (size_t)(row0 + ai * HALF + m * 16) * 1024 + col0 + bj * HALF);
#pragma unroll
        for (int ai = 0; ai < 2; ++ai)
#pragma unroll
            for (int m = 0; m < 4; ++m) {
                const int row = row0 + ai * HALF + m * 16; const size_t off = (size_t)row * 1024 + col0; float q = 0.f, mx = 0.f;
#pragma unroll
                for (int bj = 0; bj < 2; ++bj) {
                    const u32x4 p = pre[ai][m][bj];
                    const f32x4 v0 = bf16lo4(p.x, p.y) + acc[ai][bj][m][0] * alpha, v1 = bf16lo4(p.z, p.w) + acc[ai][bj][m][1] * alpha;
                    u32x4 w; w.x = cvt_pk_bf16(v0[0], v0[1]); w.y = cvt_pk_bf16(v0[2], v0[3]); w.z = cvt_pk_bf16(v1[0], v1[1]); w.w = cvt_pk_bf16(v1[2], v1[3]);
                    *(u32x4*)(Xb + off + bj * HALF) = w;
                    q += ((v0[0] * v0[0] + v0[1] * v0[1]) + (v0[2] * v0[2] + v0[3] * v0[3])) + ((v1[0] * v1[0] + v1[1] * v1[1]) + (v1[2] * v1[2] + v1[3] * v1[3]));
                    if (AM) { const f32x4 a0 = __builtin_elementwise_abs(v0), a1 = __builtin_elementwise_abs(v1); mx = fmaxf(mx, fmaxf(fmaxf(fmaxf(a0[0], a0[1]), fmaxf(a0[2], a0[3])), fmaxf(fmaxf(a1[0], a1[1]), fmaxf(a1[2], a1[3])))); }
                }
                q += __shfl_xor(q, 16); q += __shfl_xor(q, 32); if (fq == 0) ss[(size_t)row * 16 + u.pn * 4 + wc] = q;
                if (AM) { mx = fmaxf(mx, __shfl_xor(mx, 16)); mx = fmaxf(mx, __shfl_xor(mx, 32)); if (fq == 0) am[(size_t)row * 16 + u.pn * 4 + wc] = mx; }
            }
    }
};

constexpr float C2A = 0.17677669529663687f * 1.4426950408889634f;
constexpr float C2B = 0.125f * 1.4426950408889634f;
template <bool Q8> struct EpiProjT {
    static constexpr bool PERM = true, AFTER_DRAIN = false, I8 = Q8;
    bf16_t* O; const float* ss; const float* qn; const float* kn; const float* cs; const float* sb;
    __device__ __forceinline__ void operator()(const f32x4 (&acc)[2][2][4][2], const Unit& u, int wr, int wc, int fr, int fq) const {
        const int pn = u.pn, row0 = u.pm * BM + wr * 64 + fr, colbase = pn * 256 + wc * 64 + 8 * fq;
        int mode = 0; float qscale = 1.0f; const float* gain = qn;
        if (pn < 2) { mode = 1; qscale = C2A; } else if (pn < 6) { mode = 0; } else if (pn < 8) { mode = 2; qscale = C2B; } else if (wc < 2) { mode = 2; gain = kn; }
        f32x4 gv[2][2];
#pragma unroll
        for (int bj = 0; bj < 2; ++bj)
#pragma unroll
            for (int n = 0; n < 2; ++n) gv[bj][n] = (mode == 2) ? *(const f32x4*)(gain + 32 * bj + 8 * fq + 4 * n) : (f32x4){1.f, 1.f, 1.f, 1.f};
        f32x4 sbv[2][2];
#pragma unroll
        for (int bj = 0; bj < 2; ++bj)
#pragma unroll
            for (int n = 0; n < 2; ++n) sbv[bj][n] = Q8 ? *(const f32x4*)(sb + pn * 256 + bj * HALF + wc * 32 + 8 * fq + 4 * n) : (f32x4){1.f, 1.f, 1.f, 1.f};
#pragma unroll
        for (int ai = 0; ai < 2; ++ai)
#pragma unroll
            for (int m = 0; m < 4; ++m) {
                const int row = row0 + ai * HALF + m * 16;
                const float rs = Q8 ? ss[row] : rstd_from_parts_q(ss, row, fq);
                f32x4 v[2][2];
#pragma unroll
                for (int bj = 0; bj < 2; ++bj)
#pragma unroll
                    for (int n = 0; n < 2; ++n) { if constexpr (Q8) v[bj][n] = __builtin_convertvector(__builtin_bit_cast(i32x4, acc[ai][bj][m][n]), f32x4) * sbv[bj][n] * rs; else v[bj][n] = acc[ai][bj][m][n] * rs; }
                if (mode == 2) {
                    float q = 0.f;
#pragma unroll
                    for (int bj = 0; bj < 2; ++bj)
#pragma unroll
                        for (int n = 0; n < 2; ++n) q += (v[bj][n][0] * v[bj][n][0] + v[bj][n][1] * v[bj][n][1]) + (v[bj][n][2] * v[bj][n][2] + v[bj][n][3] * v[bj][n][3]);
                    q += __shfl_xor(q, 16); q += __shfl_xor(q, 32);
                    const float hr = rsqrtf(q * (1.0f / 64.0f) + RMS_EPS);
                    const int s = row & 4095;
#pragma unroll
                    for (int bj = 0; bj < 2; ++bj) {
                        const int pos = bj ? (s & 63) : (s >> 6);
                        const f32x4* t = (const f32x4*)(cs + (size_t)(pos * 16 + 4 * fq) * 2);
#pragma unroll
                        for (int n = 0; n < 2; ++n) {
                            const f32x4 x = v[bj][n] * hr * gv[bj][n], c = t[n];
                            f32x4 y; y[0] = x[0] * c[0] - x[1] * c[1]; y[1] = x[0] * c[1] + x[1] * c[0]; y[2] = x[2] * c[2] - x[3] * c[3]; y[3] = x[2] * c[3] + x[3] * c[2];
                            v[bj][n] = y * qscale;
                        }
                    }
                } else if (mode == 1) {
#pragma unroll
                    for (int bj = 0; bj < 2; ++bj)
#pragma unroll
                        for (int n = 0; n < 2; ++n) v[bj][n] = v[bj][n] * qscale;
                }
#pragma unroll
                for (int bj = 0; bj < 2; ++bj) {
                    u32x4 w; w.x = cvt_pk_bf16(v[bj][0][0], v[bj][0][1]); w.y = cvt_pk_bf16(v[bj][0][2], v[bj][0][3]); w.z = cvt_pk_bf16(v[bj][1][0], v[bj][1][1]); w.w = cvt_pk_bf16(v[bj][1][2], v[bj][1][3]);
                    *(u32x4*)(O + (size_t)row * 2304 + colbase + 32 * bj) = w;
                }
                asm volatile("" ::: "memory");
            }
    }
};
template <class Epi, class Sched, bool ALIGN_EPI = false, bool SP2 = false, bool BLK = false>
__device__ __forceinline__ void gemm_phase(PG8_LAS unsigned char* lds, const Gemm g, const Sched& S, const Epi& E) {
    const int tid = threadIdx.x, wid = __builtin_amdgcn_readfirstlane(tid >> 6), lane = tid & 63, wr = wid >> 2, wc = wid & 3, fr = lane & 15, fq = lane >> 4;
    const int K = g.K, nt = K / BK;
    unsigned voffA[2], voffB[2];
#pragma unroll
    for (int i = 0; i < 2; ++i) { int R, C; stage_rc(tid * 16 + i * 8192, R, C); const int Rb = Epi::PERM ? ((R & ~31) + perm32(R & 31)) : R;
        voffA[i] = BLK ? (unsigned)(R * 128 + C * 2) : (unsigned)(R * K + C) * 2u; voffB[i] = BLK ? (unsigned)(Rb * 128 + C * 2) : (unsigned)(Rb * K + C) * 2u; }
    const size_t kstep = BLK ? (size_t)32768 : (size_t)(BK * 2);
    const size_t hstep = BLK ? (size_t)16384 : (size_t)HALF * K * 2;
    const size_t tstep = BLK ? (size_t)(K / BK) * 32768 : 2 * hstep;
    const unsigned ldsw = (unsigned)wid * 1024u;
    const int aoff = lds_byte(wr * 64 + fr, fq * 8), boff = lds_byte(wc * 32 + fr, fq * 8);
#define PG8_SA(b, h) (((b) * 2 + (h)) * HTB)
#define PG8_SB(b, h) ((4 + (b) * 2 + (h)) * HTB)
#define PG8_STAGE(bufoff, gbase, voff) do { _Pragma("unroll") for (int _i = 0; _i < 2; ++_i) \
        __builtin_amdgcn_global_load_lds((const unsigned*)((const char*)(gbase) + (voff)[_i]), (PG8_LAS unsigned*)(lds + (bufoff) + ldsw + _i * 8192), 16, 0, 0); } while (0)
#define PG8_LDA(dst, b, h) do { _Pragma("unroll") for (int m = 0; m < 4; ++m) _Pragma("unroll") for (int k = 0; k < 2; ++k) dst[m][k] = *(const PG8_LAS bf16x8*)(lds + PG8_SA(b, h) + aoff + m * 2048 + k * 1024); } while (0)
#define PG8_LDB(dst, b, h) do { _Pragma("unroll") for (int n = 0; n < 2; ++n) _Pragma("unroll") for (int k = 0; k < 2; ++k) dst[n][k] = *(const PG8_LAS bf16x8*)(lds + PG8_SB(b, h) + boff + n * 2048 + k * 1024); } while (0)
#define PG8_MMA(ai, bj, At, Bt) do { __builtin_amdgcn_s_setprio(1); _Pragma("unroll") for (int m = 0; m < 4; ++m) _Pragma("unroll") for (int n = 0; n < 2; ++n) _Pragma("unroll") for (int k = 0; k < 2; ++k) \
        acc[ai][bj][m][n] = pg8_mma<Epi::I8>(Bt[n][k], At[m][k], acc[ai][bj][m][n]); __builtin_amdgcn_s_setprio(0); } while (0)
#define PG8_WAIT_V(n) asm volatile("s_waitcnt vmcnt(" #n ")" ::: "memory")
#define PG8_WAIT_L(n) asm volatile("s_waitcnt lgkmcnt(" #n ")" ::: "memory")
#define PG8_BAR __builtin_amdgcn_s_barrier()
#define PG8_SCHED __builtin_amdgcn_sched_barrier(0)
    Unit cur, nxt; int ui = 0;
    if (!S.next(0, cur)) return;
    f32x4 acc[2][2][4][2];
#pragma unroll
    for (int a = 0; a < 2; ++a)
#pragma unroll
        for (int b = 0; b < 2; ++b)
#pragma unroll
            for (int m = 0; m < 4; ++m)
#pragma unroll
                for (int n = 0; n < 2; ++n) acc[a][b][m][n] = (f32x4){0.f, 0.f, 0.f, 0.f};
    bf16x8 At[4][2], B0[2][2], B1[2][2];
    const char* cA = (const char*)g.A + (size_t)cur.pm * tstep; const char* cB = (const char*)g.Bt + (size_t)cur.pn * tstep;
    S.a_ready(cur);
    if constexpr (SP2) {
        PG8_STAGE(PG8_SB(0, 0), cB, voffB); PG8_STAGE(PG8_SB(0, 1), cB + hstep, voffB); PG8_STAGE(PG8_SA(0, 0), cA, voffA); PG8_STAGE(PG8_SA(0, 1), cA + hstep, voffA);
        if (wr == 1) PG8_BAR;
        PG8_WAIT_V(2); PG8_BAR;
        PG8_STAGE(PG8_SB(1, 0), cB + kstep, voffB); PG8_STAGE(PG8_SA(1, 0), cA + kstep, voffA); PG8_STAGE(PG8_SB(1, 1), cB + hstep + kstep, voffB);
        PG8_WAIT_V(6); PG8_BAR;
    } else {
        PG8_STAGE(PG8_SB(0, 0), cB, voffB); PG8_STAGE(PG8_SA(0, 0), cA, voffA); PG8_STAGE(PG8_SB(0, 1), cB + hstep, voffB); PG8_STAGE(PG8_SA(0, 1), cA + hstep, voffA);
        if (wr == 1) PG8_BAR;
        PG8_WAIT_V(4); PG8_BAR;
        PG8_STAGE(PG8_SB(1, 0), cB + kstep, voffB); PG8_STAGE(PG8_SA(1, 0), cA + kstep, voffA); PG8_STAGE(PG8_SB(1, 1), cB + hstep + kstep, voffB);
        PG8_WAIT_V(6); PG8_BAR;
    }
    for (;;) {
        const bool has_next = S.next(ui + 1, nxt);
        const char* nA = has_next ? (const char*)g.A + (size_t)nxt.pm * tstep : cA; const char* nB = has_next ? (const char*)g.Bt + (size_t)nxt.pn * tstep : cB;
        for (int t = 0; t < nt; t += 2) {
            const bool last = (t == nt - 2);
            const char* a1 = cA + (size_t)(t + 1) * kstep;
            const char* a2 = last ? nA : cA + (size_t)(t + 2) * kstep; const char* b2 = last ? nB : cB + (size_t)(t + 2) * kstep;
            const char* a3 = a2 + kstep; const char* b3 = b2 + kstep;
            if (last && has_next) S.a_ready(nxt);
            if constexpr (SP2) {
            PG8_LDB(B0, 0, 0); PG8_LDB(B1, 0, 1); PG8_SCHED; PG8_LDA(At, 0, 0); PG8_STAGE(PG8_SA(1, 1), a1 + hstep, voffA);
            PG8_WAIT_V(8); PG8_WAIT_L(0); PG8_BAR; PG8_MMA(0, 0, At, B0); PG8_MMA(0, 1, At, B1); PG8_BAR; PG8_SCHED;
            PG8_LDA(At, 0, 1); PG8_STAGE(PG8_SB(0, 0), b2, voffB); PG8_STAGE(PG8_SB(0, 1), b2 + hstep, voffB); PG8_STAGE(PG8_SA(0, 0), a2, voffA);
            PG8_WAIT_V(8); PG8_WAIT_L(0); PG8_BAR; PG8_MMA(1, 0, At, B0); PG8_MMA(1, 1, At, B1); PG8_BAR; PG8_SCHED;
            PG8_LDB(B0, 1, 0); PG8_LDB(B1, 1, 1); PG8_SCHED; PG8_LDA(At, 1, 0); PG8_STAGE(PG8_SA(0, 1), a2 + hstep, voffA);
            PG8_WAIT_V(8); PG8_WAIT_L(0); PG8_BAR; PG8_MMA(0, 0, At, B0); PG8_MMA(0, 1, At, B1); PG8_BAR; PG8_SCHED;
            PG8_LDA(At, 1, 1); PG8_STAGE(PG8_SB(1, 0), b3, voffB); PG8_STAGE(PG8_SB(1, 1), b3 + hstep, voffB); PG8_STAGE(PG8_SA(1, 0), a3, voffA);
            PG8_WAIT_V(8); PG8_WAIT_L(0); PG8_BAR; PG8_MMA(1, 0, At, B0); PG8_MMA(1, 1, At, B1); PG8_BAR; PG8_SCHED;
            } else {
            PG8_LDB(B0, 0, 0); PG8_SCHED; PG8_LDA(At, 0, 0); PG8_STAGE(PG8_SA(1, 1), a1 + hstep, voffA);
            PG8_WAIT_L(8); PG8_BAR; PG8_WAIT_L(0); PG8_MMA(0, 0, At, B0); PG8_BAR; PG8_SCHED;
            PG8_LDB(B1, 0, 1); PG8_STAGE(PG8_SB(0, 0), b2, voffB);
            PG8_BAR; PG8_WAIT_L(0); PG8_MMA(0, 1, At, B1); PG8_BAR;
            PG8_LDA(At, 0, 1); PG8_STAGE(PG8_SA(0, 0), a2, voffA);
            PG8_BAR; PG8_WAIT_L(0); PG8_MMA(1, 0, At, B0); PG8_BAR; PG8_SCHED;
            PG8_STAGE(PG8_SB(0, 1), b2 + hstep, voffB);
            PG8_WAIT_V(6); PG8_BAR; PG8_MMA(1, 1, At, B1); PG8_BAR;
            PG8_LDB(B0, 1, 0); PG8_SCHED; PG8_LDA(At, 1, 0); PG8_STAGE(PG8_SA(0, 1), a2 + hstep, voffA);
            PG8_WAIT_L(8); PG8_BAR; PG8_WAIT_L(0); PG8_MMA(0, 0, At, B0); PG8_BAR; PG8_SCHED;
            PG8_LDB(B1, 1, 1); PG8_STAGE(PG8_SB(1, 0), b3, voffB);
            PG8_BAR; PG8_WAIT_L(0); PG8_MMA(0, 1, At, B1); PG8_BAR;
            PG8_LDA(At, 1, 1); PG8_STAGE(PG8_SA(1, 0), a3, voffA);
            PG8_BAR; PG8_WAIT_L(0); PG8_MMA(1, 0, At, B0); PG8_BAR; PG8_SCHED;
            PG8_STAGE(PG8_SB(1, 1), b3 + hstep, voffB);
            PG8_WAIT_V(6); PG8_BAR; PG8_MMA(1, 1, At, B1); PG8_BAR;
            }
        }
        if constexpr (ALIGN_EPI) { if (wr == 0) PG8_BAR; }
        if constexpr (!Epi::AFTER_DRAIN) { E(acc, cur, wr, wc, fr, fq); S.done(cur); }
        if (!has_next) break;
#pragma unroll
        for (int a = 0; a < 2; ++a)
#pragma unroll
            for (int b = 0; b < 2; ++b)
#pragma unroll
                for (int m = 0; m < 4; ++m)
#pragma unroll
                    for (int n = 0; n < 2; ++n) acc[a][b][m][n] = (f32x4){0.f, 0.f, 0.f, 0.f};
        cur = nxt; cA = nA; cB = nB; ++ui;
        if constexpr (ALIGN_EPI) { if (wr == 1) PG8_BAR; }
    }
    PG8_WAIT_V(0);
    if constexpr (!ALIGN_EPI) { if (wr == 0) PG8_BAR; }
    PG8_BAR;
    if constexpr (Epi::AFTER_DRAIN) { E.fused(acc, cur, wr, wc, fr, fq, lds, wid, lane); S.done(cur); }
#undef PG8_SA
#undef PG8_SB
#undef PG8_STAGE
#undef PG8_LDA
#undef PG8_LDB
#undef PG8_MMA
#undef PG8_WAIT_V
#undef PG8_WAIT_L
#undef PG8_BAR
#undef PG8_SCHED
}
}
namespace att {
using bf16 = unsigned short;
using bf16x8 = __attribute__((ext_vector_type(8))) short;
using s16x4 = __attribute__((ext_vector_type(4))) short;
using f32x16 = __attribute__((ext_vector_type(16))) float;
using u32x4 = __attribute__((ext_vector_type(4))) unsigned;
using f32x4 = __attribute__((ext_vector_type(4))) float;
constexpr int SEQ = 4096, PITCH = 2304, KVBLK = 64, NT = SEQ / KVBLK, NW = 8;
constexpr int NSLOT = 3, SLOTB = 8192;
constexpr int LDS_K = 0, LDS_V = NSLOT * SLOTB, LDS_WS = 2 * NSLOT * SLOTB, LDS_TBL = LDS_WS + NW * 256, LDS_OST = LDS_TBL + 2048, LDS_BYTES = LDS_OST + NW * 8192;
constexpr int TBL_N = 384, TBL_OFF = 192;
__device__ __forceinline__ int crow(int r, int hi) { return (r & 3) + 8 * (r >> 2) + 4 * hi; }
#define ATT_SBAR() __builtin_amdgcn_sched_barrier(0)
__device__ __forceinline__ void glds16(const void* gsrc, unsigned lds_dst) { unsigned keep;
  asm volatile("s_mov_b32 %0, m0\n\ts_mov_b32 m0, %2\n\ts_nop 0\n\tglobal_load_lds_dwordx4 %1, off\n\ts_mov_b32 m0, %0" : "=&s"(keep) : "v"(gsrc), "s"(lds_dst) : "memory"); }
typedef float f32x2_t __attribute__((ext_vector_type(2))); typedef __bf16 bf16x2_t __attribute__((ext_vector_type(2)));
__device__ __forceinline__ unsigned cvtpk_s(float lo, float hi) { f32x2_t v = {lo, hi}; bf16x2_t b = __builtin_convertvector(v, bf16x2_t); return __builtin_bit_cast(unsigned, b); }
__device__ __forceinline__ void pv(f32x16* o, int vb, bf16x8 pa0, bf16x8 pa1, bf16x8 pa2, bf16x8 pa3) {
  #pragma unroll
  for (int d0 = 0; d0 < 2; ++d0) { s16x4 lo[4], hi[4];
    #pragma unroll
    for (int ks = 0; ks < 4; ++ks) {
      asm volatile("ds_read_b64_tr_b16 %0,%1 offset:%c2" : "=&v"(lo[ks]) : "v"(vb), "i"(d0 * 4096 + ks * 1024) : "memory");
      asm volatile("ds_read_b64_tr_b16 %0,%1 offset:%c2" : "=&v"(hi[ks]) : "v"(vb), "i"(d0 * 4096 + ks * 1024 + 512) : "memory"); }
    asm volatile("s_waitcnt lgkmcnt(0)" ::: "memory"); ATT_SBAR();
    #define ATT_PK(k) (bf16x8){lo[k][0], lo[k][1], lo[k][2], lo[k][3], hi[k][0], hi[k][1], hi[k][2], hi[k][3]}
    o[d0] = __builtin_amdgcn_mfma_f32_32x32x16_bf16(pa0, ATT_PK(0), o[d0], 0, 0, 0);
    o[d0] = __builtin_amdgcn_mfma_f32_32x32x16_bf16(pa1, ATT_PK(1), o[d0], 0, 0, 0);
    o[d0] = __builtin_amdgcn_mfma_f32_32x32x16_bf16(pa2, ATT_PK(2), o[d0], 0, 0, 0);
    o[d0] = __builtin_amdgcn_mfma_f32_32x32x16_bf16(pa3, ATT_PK(3), o[d0], 0, 0, 0);
    #undef ATT_PK
  }
}
typedef __attribute__((address_space(3))) const char* lds_cptr;
typedef __attribute__((address_space(3))) float* lds_fptr;

template <bool MODEA>
__device__ __forceinline__ void attn_unit_simple(int b, int h, int qb, const bf16* QKV, bf16* AO, char* shm, const float* bias_tab, float lam, const float* subln) {
  const int tid = threadIdx.x, lane = tid & 63, r32 = lane & 31, hi = lane >> 5; const int wid = __builtin_amdgcn_readfirstlane(tid >> 6);
  const int part = MODEA ? (wid >> 2) : 0, w4 = MODEA ? (wid & 3) : wid;
  const int q0 = MODEA ? qb * 128 : qb * 256, qw0 = q0 + 32 * w4;
  const long rowbase = (long)b * SEQ;
  const int qcol = MODEA ? h * 64 + 32 * part : 1536 + h * 64;
  const int kcol = MODEA ? 512 + h * 64 : 2048 + (h >> 2) * 64;
  const int vcol = MODEA ? 1024 + h * 64 : 2176 + (h >> 2) * 64;
  constexpr int NDK = MODEA ? 2 : 4;
  const bf16* Qw = QKV + (rowbase + qw0) * PITCH + qcol;
  const bf16* Kh = QKV + rowbase * PITCH + kcol; const bf16* Vh = QKV + rowbase * PITCH + vcol;
  const unsigned lds0 = (unsigned)(uintptr_t)shm;
  const lds_cptr shm3 = (lds_cptr)shm;
  lds_fptr wsf = (lds_fptr)(shm3 + LDS_WS) + wid * 64;
  lds_fptr tbl = (lds_fptr)(shm3 + LDS_TBL);
  const bf16* ksrc = Kh + (long)lane * PITCH + wid * 8;
  const bf16* vsrc = Vh + (long)(16 * (wid & 3) + (lane >> 2)) * PITCH + (wid >> 2) * 32 + (lane & 3) * 8;
  const unsigned kdst = lds0 + LDS_K + wid * 1024, vdst = lds0 + LDS_V + wid * 1024;
  const int vb0 = (int)(lds0 + LDS_V) + ((lane >> 4) & 1) * 32 + (lane & 3) * 8 + (4 * hi + ((lane & 15) >> 2)) * 64;
  const lds_cptr kp0 = shm3 + LDS_K + part * 4096 + hi * 1024 + r32 * 16;
  if (MODEA) { if (tid < TBL_N) tbl[tid] = bias_tab[h * TBL_N + tid]; }
  bf16x8 qr[NDK];
  #pragma unroll
  for (int d0 = 0; d0 < NDK; ++d0) qr[d0] = *reinterpret_cast<const bf16x8*>(&Qw[(long)r32 * PITCH + d0 * 16 + hi * 8]);
  float m_run = -1e30f, l_reg = 0.f; f32x16 o[2]; o[0] = f32x16{}; o[1] = f32x16{};
  float cL = 0.f, cR = 0.f;
  for (int t = 0; t < NT; ++t) {
    asm volatile("s_waitcnt lgkmcnt(0)\n\ts_barrier" ::: "memory");
    glds16(ksrc + (long)t * KVBLK * PITCH, (unsigned)__builtin_amdgcn_readfirstlane(kdst));
    glds16(vsrc + (long)t * KVBLK * PITCH, (unsigned)__builtin_amdgcn_readfirstlane(vdst));
    asm volatile("s_waitcnt vmcnt(0)\n\ts_barrier" ::: "memory");
    if (MODEA && t == 0) { cL = tbl[0]; cR = tbl[TBL_N - 1]; }
    f32x16 p0, p1;
    #pragma unroll
    for (int d0 = 0; d0 < NDK; ++d0) {
      const bf16x8 b0 = *(const __attribute__((address_space(3))) bf16x8*)(kp0 + d0 * 2048);
      const bf16x8 b1 = *(const __attribute__((address_space(3))) bf16x8*)(kp0 + d0 * 2048 + 512);
      if (d0 == 0) { p0 = __builtin_amdgcn_mfma_f32_32x32x16_bf16(b0, qr[0], f32x16{}, 0, 0, 0); p1 = __builtin_amdgcn_mfma_f32_32x32x16_bf16(b1, qr[0], f32x16{}, 0, 0, 0); }
      else { p0 = __builtin_amdgcn_mfma_f32_32x32x16_bf16(b0, qr[d0], p0, 0, 0, 0); p1 = __builtin_amdgcn_mfma_f32_32x32x16_bf16(b1, qr[d0], p1, 0, 0, 0); }
    }
    if (MODEA) {
      const int kt = t * KVBLK;
      if (kt + 63 - qw0 <= -91) {
        #pragma unroll
        for (int r = 0; r < 16; ++r) { p0[r] += cL; p1[r] += cL; }
      } else if (kt - (qw0 + 31) >= 91) {
        #pragma unroll
        for (int r = 0; r < 16; ++r) { p0[r] += cR; p1[r] += cR; }
      } else {
        const lds_fptr tb = tbl + (kt - (qw0 + r32) + TBL_OFF + 4 * hi);
        #pragma unroll
        for (int r = 0; r < 16; ++r) { p0[r] += tb[(r & 3) + 8 * (r >> 2)]; p1[r] += tb[32 + (r & 3) + 8 * (r >> 2)]; }
      }
    }
    float rm = fmaxf(p0[0], p1[0]);
    #pragma unroll
    for (int r = 1; r < 16; ++r) rm = fmaxf(rm, fmaxf(p0[r], p1[r]));
    { auto rr = __builtin_amdgcn_permlane32_swap(__float_as_uint(rm), __float_as_uint(rm), false, false); rm = fmaxf(__uint_as_float(rr[0]), __uint_as_float(rr[1])); }
    const float mnew = fmaxf(m_run, rm);
    if (__any(mnew > m_run)) {
      const float alpha = __builtin_amdgcn_exp2f(m_run - mnew);
      l_reg *= alpha; m_run = mnew;
      if (hi == 0) wsf[r32] = alpha;
      asm volatile("s_waitcnt lgkmcnt(0)" ::: "memory");
      #pragma unroll
      for (int d = 0; d < 2; ++d)
        #pragma unroll
        for (int r = 0; r < 16; ++r) o[d][r] *= wsf[crow(r, hi)];
    }
    float sacc = 0.f;
    #pragma unroll
    for (int r = 0; r < 16; ++r) { p0[r] = __builtin_amdgcn_exp2f(p0[r] - m_run); p1[r] = __builtin_amdgcn_exp2f(p1[r] - m_run); sacc += p0[r] + p1[r]; }
    l_reg += sacc;
    u32x4 pw0, pw1, pw2, pw3;
    pw0 = (u32x4){cvtpk_s(p0[0], p0[1]), cvtpk_s(p0[2], p0[3]), cvtpk_s(p0[4], p0[5]), cvtpk_s(p0[6], p0[7])};
    pw1 = (u32x4){cvtpk_s(p0[8], p0[9]), cvtpk_s(p0[10], p0[11]), cvtpk_s(p0[12], p0[13]), cvtpk_s(p0[14], p0[15])};
    pw2 = (u32x4){cvtpk_s(p1[0], p1[1]), cvtpk_s(p1[2], p1[3]), cvtpk_s(p1[4], p1[5]), cvtpk_s(p1[6], p1[7])};
    pw3 = (u32x4){cvtpk_s(p1[8], p1[9]), cvtpk_s(p1[10], p1[11]), cvtpk_s(p1[12], p1[13]), cvtpk_s(p1[14], p1[15])};
    ATT_SBAR();
    pv(o, vb0, __builtin_bit_cast(bf16x8, pw0), __builtin_bit_cast(bf16x8, pw1), __builtin_bit_cast(bf16x8, pw2), __builtin_bit_cast(bf16x8, pw3));
  }
  { auto rr = __builtin_amdgcn_permlane32_swap(__float_as_uint(l_reg), __float_as_uint(l_reg), false, false); l_reg = __uint_as_float(rr[0]) + __uint_as_float(rr[1]); }
  if (hi == 0) wsf[32 + r32] = l_reg;
  asm volatile("s_waitcnt lgkmcnt(0)" ::: "memory");
  float rli[16];
  #pragma unroll
  for (int r = 0; r < 16; ++r) rli[r] = __builtin_amdgcn_rcpf(wsf[32 + crow(r, hi)]);
  if (!MODEA) {
    bf16* Ow = AO + (rowbase + qw0) * 1024 + 512 + h * 64;
    __attribute__((address_space(3))) bf16* stg = (__attribute__((address_space(3))) bf16*)(shm3 + LDS_OST) + wid * 4096;
    #pragma unroll
    for (int r = 0; r < 16; ++r) { const int orow = crow(r, hi);
      #pragma unroll
      for (int d0 = 0; d0 < 2; ++d0) stg[orow * 64 + d0 * 32 + r32] = (bf16)(cvtpk_s(o[d0][r] * rli[r], 0.f) & 0xffffu); }
    asm volatile("s_waitcnt lgkmcnt(0)" ::: "memory");
    #pragma unroll
    for (int i = 0; i < 4; ++i) { const int row = i * 8 + (lane >> 3), ch = lane & 7; const u32x4 v = *(const __attribute__((address_space(3))) u32x4*)(stg + row * 64 + ch * 8); *(u32x4*)(Ow + (long)row * 1024 + ch * 8) = v; }
  } else {
    lds_fptr stg = (lds_fptr)(shm3 + LDS_OST) + wid * 2048;
    #pragma unroll
    for (int r = 0; r < 16; ++r) { const int orow = crow(r, hi);
      #pragma unroll
      for (int d0 = 0; d0 < 2; ++d0) stg[orow * 64 + d0 * 32 + r32] = o[d0][r] * rli[r]; }
    asm volatile("s_waitcnt lgkmcnt(0)\n\ts_barrier" ::: "memory");
    const lds_fptr s1 = (lds_fptr)(shm3 + LDS_OST) + w4 * 2048, s2 = s1 + 4 * 2048;
    bf16* Ow = AO + (rowbase + q0 + 32 * w4) * 1024 + h * 64;
    #pragma unroll
    for (int i = 0; i < 2; ++i) {
      const int row = 16 * part + i * 8 + (lane >> 3), ch = lane & 7;
      const f32x4 a0 = *(const __attribute__((address_space(3))) f32x4*)(s1 + row * 64 + ch * 8), a1 = *(const __attribute__((address_space(3))) f32x4*)(s1 + row * 64 + ch * 8 + 4);
      const f32x4 b0 = *(const __attribute__((address_space(3))) f32x4*)(s2 + row * 64 + ch * 8), b1 = *(const __attribute__((address_space(3))) f32x4*)(s2 + row * 64 + ch * 8 + 4);
      const f32x4 d0v = a0 - b0 * lam, d1v = a1 - b1 * lam;
      float q = ((d0v[0] * d0v[0] + d0v[1] * d0v[1]) + (d0v[2] * d0v[2] + d0v[3] * d0v[3])) + ((d1v[0] * d1v[0] + d1v[1] * d1v[1]) + (d1v[2] * d1v[2] + d1v[3] * d1v[3]));
      q += __shfl_xor(q, 1); q += __shfl_xor(q, 2); q += __shfl_xor(q, 4);
      const float rs = rsqrtf(q * (1.0f / 64.0f) + 1e-6f) * 0.8f;
      const f32x4 g0 = *(const f32x4*)(subln + ch * 8), g1 = *(const f32x4*)(subln + ch * 8 + 4);
      const f32x4 y0 = d0v * rs * g0, y1 = d1v * rs * g1;
      u32x4 w; w.x = cvtpk_s(y0[0], y0[1]); w.y = cvtpk_s(y0[2], y0[3]); w.z = cvtpk_s(y1[0], y1[1]); w.w = cvtpk_s(y1[2], y1[3]);
      *(u32x4*)(Ow + (long)row * 1024 + ch * 8) = w;
    }
  }
  asm volatile("s_waitcnt lgkmcnt(0)\n\ts_barrier" ::: "memory");
}

__device__ __forceinline__ float max3f(float a, float b, float c) { float r; asm("v_max3_f32 %0, %1, %2, %3" : "=v"(r) : "v"(a), "v"(b), "v"(c)); return r; }
__device__ __forceinline__ float max2f(float a, float b) { float r; asm("v_max_f32_e32 %0, %1, %2" : "=v"(r) : "v"(a), "v"(b)); return r; }
__device__ __forceinline__ float fadd_s(float a, float b) { float r; asm("v_add_f32_e32 %0, %1, %2" : "=v"(r) : "v"(a), "v"(b)); return r; }
__device__ __forceinline__ float fsub_s(float a, float b) { float r; asm("v_sub_f32_e32 %0, %1, %2" : "=v"(r) : "v"(a), "v"(b)); return r; }
#define ATT_WAIT_BAR(N) asm volatile("s_waitcnt vmcnt(" #N ") lgkmcnt(0)\n\ts_barrier" ::: "memory")
typedef short v4i16_t __attribute__((ext_vector_type(4)));
__device__ __forceinline__ void kload2(bf16x8* kf, lds_cptr kp, int j) { kf[2 * j] = *(const __attribute__((address_space(3))) bf16x8*)(kp + j * 2048); kf[2 * j + 1] = *(const __attribute__((address_space(3))) bf16x8*)(kp + j * 2048 + 512); }
__device__ __forceinline__ s16x4 vtr(lds_cptr p) { return __builtin_bit_cast(s16x4, __builtin_amdgcn_ds_read_tr16_b64_v4i16((__attribute__((address_space(3))) v4i16_t*)p)); }
__device__ __forceinline__ float rowmax(const f32x16& p0, const f32x16& p1) {
  float a = max3f(p0[0], p0[1], p1[0]), b = max3f(p0[2], p0[3], p1[1]); a = max3f(a, p1[2], p1[3]);
  #pragma unroll
  for (int r = 4; r < 16; r += 4) { a = max3f(a, p0[r], p0[r + 1]); b = max3f(b, p0[r + 2], p0[r + 3]); a = max3f(a, p1[r], p1[r + 1]); b = max3f(b, p1[r + 2], p1[r + 3]); }
  const float m = max2f(a, b);
  auto rr = __builtin_amdgcn_permlane32_swap(__float_as_uint(m), __float_as_uint(m), false, false);
  return max2f(__uint_as_float(rr[0]), __uint_as_float(rr[1]));
}
#define ATT_MFMA(a, b, c) __builtin_amdgcn_mfma_f32_32x32x16_bf16(a, b, c, 0, 0, 0)

#ifndef ATT_STAGGER
#define ATT_STAGGER 0
#endif
#ifndef ATT_RSM16
#define ATT_RSM16(modea) true
#endif
#ifndef ATT_RSM
#define ATT_RSM(modea) false
#endif
template <bool MODEA>
__device__ __forceinline__ void attn_unit(int b, int h, int qb, const bf16* QKV, bf16* AO, char* shm, const float* bias_tab, float lam, const float* subln) {
  const int tid = threadIdx.x, lane = tid & 63, r32 = lane & 31, hi = lane >> 5; const int wid = __builtin_amdgcn_readfirstlane(tid >> 6);
  const int part = MODEA ? (wid >> 2) : 0, w4 = MODEA ? (wid & 3) : wid;
  const int q0 = MODEA ? qb * 128 : qb * 256, qw0 = q0 + 32 * w4;
  const long rowbase = (long)b * SEQ;
  const int qcol = MODEA ? h * 64 + 32 * part : 1536 + h * 64;
  const int kcol = MODEA ? 512 + h * 64 : 2048 + (h >> 2) * 64;
  const int vcol = MODEA ? 1024 + h * 64 : 2176 + (h >> 2) * 64;
  constexpr int NDK = MODEA ? 2 : 4;
  constexpr bool RSM = ATT_RSM(MODEA); constexpr bool RSM16 = ATT_RSM16(MODEA);
  const bf16* Qw = QKV + (rowbase + qw0) * PITCH + qcol;
  const bf16* Kh = QKV + rowbase * PITCH + kcol; const bf16* Vh = QKV + rowbase * PITCH + vcol;
  const unsigned lds0 = (unsigned)(uintptr_t)shm;
  const lds_cptr shm3 = (lds_cptr)shm;
  lds_fptr wsf = (lds_fptr)(shm3 + LDS_WS) + wid * 64;
  __attribute__((address_space(3))) unsigned* flag = (__attribute__((address_space(3))) unsigned*)(shm3 + LDS_WS);
  lds_fptr tbl = (lds_fptr)(shm3 + LDS_TBL);
  const bf16* ksrc = Kh + (long)lane * PITCH + wid * 8;
  const bf16* vsrc = Vh + (long)(16 * (wid & 3) + (lane >> 2)) * PITCH + (wid >> 2) * 32 + (lane & 3) * 8;
  const unsigned kdst = lds0 + LDS_K + wid * 1024, vdst = lds0 + LDS_V + wid * 1024;
  #define DMA_K(t, slot) glds16(ksrc + (long)(t) * KVBLK * PITCH, (unsigned)__builtin_amdgcn_readfirstlane(kdst + (slot)))
  #define DMA_V(t, slot) glds16(vsrc + (long)(t) * KVBLK * PITCH, (unsigned)__builtin_amdgcn_readfirstlane(vdst + (slot)))
  const int vb0 = (int)(lds0 + LDS_V) + ((lane >> 4) & 1) * 32 + (lane & 3) * 8 + (4 * hi + ((lane & 15) >> 2)) * 64;
  bf16x8 kf[2 * NDK];
  const lds_cptr kp0 = shm3 + LDS_K + part * 4096 + hi * 1024 + r32 * 16;
  const lds_cptr vp0 = shm3 + LDS_V + ((lane >> 4) & 1) * 32 + (lane & 3) * 8 + (4 * hi + ((lane & 15) >> 2)) * 64;
  int tL = 0, tR = NT; float cL = 0.f, cR = 0.f;
  if (tid == 0) flag[0] = 0u;
  if (MODEA) { if (tid < TBL_N) tbl[tid] = bias_tab[h * TBL_N + tid]; cL = bias_tab[h * TBL_N]; cR = bias_tab[h * TBL_N + TBL_N - 1];
    tL = (qw0 >= 154) ? (qw0 - 154) / 64 + 1 : 0; tR = (qw0 + 122 + 63) / 64; }
  DMA_K(0, 0); DMA_V(0, 0); DMA_K(1, SLOTB);
  bf16x8 qr[NDK];
  #pragma unroll
  for (int d0 = 0; d0 < NDK; ++d0) qr[d0] = *reinterpret_cast<const bf16x8*>(&Qw[(long)r32 * PITCH + d0 * 16 + hi * 8]);
  f32x16 o[2]; o[0] = f32x16{}; o[1] = f32x16{}; f32x16 ol = f32x16{};
  f32x16 negm = f32x16{};
  if (MODEA) { const float c0_ = (0 < tL) ? cL : 0.f;
    #pragma unroll
    for (int r = 0; r < 16; ++r) negm[r] = c0_; }
  asm volatile("" : "+v"(negm));
  f32x4 ol4 = {0.f, 0.f, 0.f, 0.f}; bf16x8 bsel; { const short o1 = (((lane & 15) < 2) && ((lane & 15) == ((lane >> 4) & 1))) ? (short)0x3F80 : (short)0;
    #pragma unroll
    for (int j = 0; j < 8; ++j) bsel[j] = o1; }
  asm volatile("" : "+v"(bsel));
  bf16x8 ones; { const short o1 = (short)0x3F80;
    #pragma unroll
    for (int j = 0; j < 8; ++j) ones[j] = o1; }
  asm volatile("" : "+v"(ones));
  #define CINIT (MODEA ? negm : f32x16{})
  #define BIAS(C0, C1, t) do { if (MODEA) { if ((t) >= tL && (t) < tR) { const lds_fptr tb_ = tbl + ((t) * KVBLK - (qw0 + r32) + TBL_OFF + 4 * hi); \
      _Pragma("unroll") for (int r = 0; r < 16; ++r) { C0[r] += tb_[(r & 3) + 8 * (r >> 2)]; C1[r] += tb_[32 + (r & 3) + 8 * (r >> 2)]; } } } } while (0)
  #define REGION(t) do { if (MODEA) { if ((t) == tL || (t) == tR) { const float cn_ = ((t) < tL) ? cL : (((t) >= tR) ? cR : 0.f); \
      _Pragma("unroll") for (int r = 0; r < 16; ++r) negm[r] = cn_; asm volatile("" : "+v"(negm)); } } } while (0)
  f32x16 pA0, pA1, pB0, pB1;
  int sl_prev = 0, sl_cur = 0, sl_next = SLOTB;
  #define ROT() do { sl_prev = sl_cur; sl_cur = sl_next; sl_next = (sl_next == (NSLOT - 1) * SLOTB) ? 0 : sl_next + SLOTB; } while (0)
  DMA_K(2, 2 * SLOTB);
  ATT_WAIT_BAR(3);
  { const lds_cptr kb = kp0;
    #pragma unroll
    for (int d0 = 0; d0 < NDK; ++d0) {
      const bf16x8 b0 = *(const __attribute__((address_space(3))) bf16x8*)(kb + d0 * 2048);
      const bf16x8 b1 = *(const __attribute__((address_space(3))) bf16x8*)(kb + d0 * 2048 + 512);
      if (d0 == 0) { pA0 = ATT_MFMA(b0, qr[0], CINIT); pA1 = ATT_MFMA(b1, qr[0], CINIT); }
      else { pA0 = ATT_MFMA(b0, qr[d0], pA0); pA1 = ATT_MFMA(b1, qr[d0], pA1); } } }
  BIAS(pA0, pA1, 0);
  _Pragma("unroll") for (int r = 0; r < 16; ++r) { pA0[r] = __builtin_amdgcn_exp2f(pA0[r]); pA1[r] = __builtin_amdgcn_exp2f(pA1[r]); }
  ATT_WAIT_BAR(0);
  if (ATT_STAGGER) { DMA_V(1, SLOTB); DMA_K(3, 0); } else { DMA_K(3, 0); DMA_V(1, SLOTB); }
  ROT();
  #pragma unroll
  for (int j = 0; j < NDK; ++j) kload2(kf, kp0 + sl_cur, j);
  ATT_WAIT_BAR(2);
  if (ATT_STAGGER) { if (wid >= 4) asm volatile("s_barrier" ::: "memory"); }
  s16x4 vlo[8], vhi[8]; u32x4 pw0, pw1, pw2, pw3;
  #define PKW(P, B) cvtpk_s(P[B], P[B + 1])
  #define PAF(k) __builtin_bit_cast(bf16x8, pw##k)
  #define VFR(i) (bf16x8){vlo[i][0], vlo[i][1], vlo[i][2], vlo[i][3], vhi[i][0], vhi[i][1], vhi[i][2], vhi[i][3]}
  #define PIN(x) asm volatile("" : "+v"(x))
  #define QKG(g, C0, C1) do { if constexpr (NDK == 4) { if constexpr (((g) & 1) != 0) { if constexpr ((g) < 2) C1 = ATT_MFMA(kf[g], qr[(g) >> 1], CINIT); else C1 = ATT_MFMA(kf[g], qr[(g) >> 1], C1); } \
                                                        else { if constexpr ((g) < 2) C0 = ATT_MFMA(kf[g], qr[(g) >> 1], CINIT); else C0 = ATT_MFMA(kf[g], qr[(g) >> 1], C0); } } \
      else if constexpr (((g) & 1) == 0) { constexpr int i_ = (g) / 2; if constexpr ((i_ & 1) != 0) { if constexpr (i_ < 2) C1 = ATT_MFMA(kf[i_], qr[i_ >> 1], CINIT); else C1 = ATT_MFMA(kf[i_], qr[i_ >> 1], C1); } \
                                                        else { if constexpr (i_ < 2) C0 = ATT_MFMA(kf[i_], qr[i_ >> 1], CINIT); else C0 = ATT_MFMA(kf[i_], qr[i_ >> 1], C0); } } } while (0)
  #define ROWSUM(k) do { if constexpr (RSM) ol = ATT_MFMA(PAF(k), ones, ol); if constexpr (RSM16) ol4 = __builtin_amdgcn_mfma_f32_16x16x32_bf16(PAF(k), bsel, ol4, 0, 0, 0); } while (0)
  float l_reg = 0.f;
  #define GAPA(g, C0, C1, W0, W1, PW, RS, A0, A1, A2, A3) do { QKG(g, C0, C1); RS; if constexpr (!RSM && !RSM16) { sacc += A0; sacc += A1; sacc += A2; sacc += A3; PIN(sacc); } W0; W1; PIN(PW); ATT_SBAR(); } while (0)
  #define EX(v) __builtin_amdgcn_exp2f(v)
  #define GAPB(MF, X, B) do { MF; X[B] = EX(X[B]); X[B + 1] = EX(X[B + 1]); X[B + 2] = EX(X[B + 2]); X[B + 3] = EX(X[B + 3]); PIN(X); ATT_SBAR(); } while (0)
  #define VRD(i) do { vlo[i] = vtr(vp_ + (((i) >> 2) * 4096 + ((i) & 3) * 1024)); vhi[i] = vtr(vp_ + (((i) >> 2) * 4096 + ((i) & 3) * 1024 + 512)); } while (0)
  #define KRD(G, j) do { if constexpr ((j) < NDK) { if (G) { kload2(kf, kp0 + sl_next, j); ATT_SBAR(); } } } while (0)
  #define STEP(C0, C1, P0, P1, t, GK, GV, GL) do { ATT_SBAR(); \
    REGION(t); \
    const lds_cptr vp_ = vp0 + sl_prev; \
    float sacc = 0.f; \
    VRD(0); ATT_SBAR(); GAPA(0, C0, C1, (void)0, (void)0, pw0, (void)0, P0[0], P0[1], P0[2], P0[3]); \
    VRD(4); ATT_SBAR(); GAPA(1, C0, C1, (void)0, (void)0, pw0, (void)0, P0[4], P0[5], P0[6], P0[7]); \
    VRD(1); ATT_SBAR(); GAPA(2, C0, C1, (void)0, (void)0, pw0, (void)0, P0[8], P0[9], P0[10], P0[11]); \
    VRD(5); ATT_SBAR(); GAPA(3, C0, C1, (void)0, (void)0, pw0, (void)0, P0[12], P0[13], P0[14], P0[15]); \
    VRD(2); ATT_SBAR(); GAPA(4, C0, C1, pw0[0] = PKW(P0, 0); pw0[1] = PKW(P0, 2), pw0[2] = PKW(P0, 4); pw0[3] = PKW(P0, 6), pw0, (void)0, P1[0], P1[1], P1[2], P1[3]); \
    VRD(6); ATT_SBAR(); GAPA(5, C0, C1, pw1[0] = PKW(P0, 8); pw1[1] = PKW(P0, 10), pw1[2] = PKW(P0, 12); pw1[3] = PKW(P0, 14), pw1, (void)0, P1[4], P1[5], P1[6], P1[7]); \
    VRD(3); ATT_SBAR(); GAPA(6, C0, C1, pw2[0] = PKW(P1, 0); pw2[1] = PKW(P1, 2), pw2[2] = PKW(P1, 4); pw2[3] = PKW(P1, 6), pw2, ROWSUM(0), P1[8], P1[9], P1[10], P1[11]); \
    VRD(7); ATT_SBAR(); GAPA(7, C0, C1, pw3[0] = PKW(P1, 8); pw3[1] = PKW(P1, 10), pw3[2] = PKW(P1, 12); pw3[3] = PKW(P1, 14), pw3, ROWSUM(1), P1[12], P1[13], P1[14], P1[15]); \
    l_reg += sacc; \
    MIDW(t); \
    if (ATT_STAGGER) { if (GV) { DMA_V((t) + 1, sl_next); } if (GK) { DMA_K((t) + 3, sl_cur); } } else { if (GK) { DMA_K((t) + 3, sl_cur); } if (GV) { DMA_V((t) + 1, sl_next); } } \
    BIAS(C0, C1, t); \
    ATT_SBAR(); \
    GAPB(o[0] = ATT_MFMA(PAF(0), VFR(0), o[0]); ROWSUM(2), C0, 0); \
    GAPB(o[1] = ATT_MFMA(PAF(0), VFR(4), o[1]); ROWSUM(3), C0, 4); \
    KRD(GL, 0); GAPB(o[0] = ATT_MFMA(PAF(1), VFR(1), o[0]), C0, 8); \
    KRD(GL, 1); GAPB(o[1] = ATT_MFMA(PAF(1), VFR(5), o[1]), C0, 12); \
    KRD(GL, 2); GAPB(o[0] = ATT_MFMA(PAF(2), VFR(2), o[0]), C1, 0); \
    KRD(GL, 3); GAPB(o[1] = ATT_MFMA(PAF(2), VFR(6), o[1]), C1, 4); \
    GAPB(o[0] = ATT_MFMA(PAF(3), VFR(3), o[0]), C1, 8); \
    GAPB(o[1] = ATT_MFMA(PAF(3), VFR(7), o[1]), C1, 12); \
    } while (0)
  #define MIDW(tt) do { if (ATT_STAGGER) { if ((tt) + 2 < NT) { ATT_WAIT_BAR(1); } else { ATT_WAIT_BAR(0); } } } while (0)
  #define ENDW(tt) do { if ((tt) + 3 < NT) { ATT_WAIT_BAR(2); } else if ((tt) + 2 < NT) { ATT_WAIT_BAR(1); } else { ATT_WAIT_BAR(0); } } while (0)
  int t = 1;
  for (; t + 5 < NT; t += 2) {
    STEP(pB0, pB1, pA0, pA1, t, true, true, true);       ATT_WAIT_BAR(2); ROT();
    STEP(pA0, pA1, pB0, pB1, t + 1, true, true, true);   ATT_WAIT_BAR(2); ROT();
  }
  for (; t + 1 < NT; t += 2) {
    STEP(pB0, pB1, pA0, pA1, t, (t + 3 < NT), (t + 1 < NT), (t + 1 < NT));       ENDW(t);     ROT();
    STEP(pA0, pA1, pB0, pB1, t + 1, (t + 4 < NT), (t + 2 < NT), (t + 2 < NT));   ENDW(t + 1); ROT();
  }
  STEP(pB0, pB1, pA0, pA1, NT - 1, false, false, false);
  if (ATT_STAGGER) { ATT_WAIT_BAR(0); if (wid < 4) asm volatile("s_barrier" ::: "memory"); }
  { pw0 = (u32x4){PKW(pB0, 0), PKW(pB0, 2), PKW(pB0, 4), PKW(pB0, 6)}; pw1 = (u32x4){PKW(pB0, 8), PKW(pB0, 10), PKW(pB0, 12), PKW(pB0, 14)};
    pw2 = (u32x4){PKW(pB1, 0), PKW(pB1, 2), PKW(pB1, 4), PKW(pB1, 6)}; pw3 = (u32x4){PKW(pB1, 8), PKW(pB1, 10), PKW(pB1, 12), PKW(pB1, 14)};
    if constexpr (!RSM && !RSM16) { float sacc = 0.f; _Pragma("unroll") for (int r = 0; r < 16; ++r) sacc += pB0[r] + pB1[r]; l_reg += sacc; }
    ATT_SBAR(); ROWSUM(0); ROWSUM(1); ROWSUM(2); ROWSUM(3); pv(o, vb0 + sl_cur, PAF(0), PAF(1), PAF(2), PAF(3)); }
  #undef PKW
  #undef PAF
  #undef VFR
  #undef PIN
  #undef QKG
  #undef ROWSUM
  #undef GAPA
  #undef GAPB
  #undef EX
  #undef VRD
  #undef KRD
  #undef STEP
  #undef ENDW
  #undef MIDW
  #undef CINIT
  float rli[16]; bool bad = false;
  if constexpr (RSM16) {
    if ((lane & 15) < 2) { const int qb_ = 16 * (lane & 15) + 4 * (lane >> 4);
      #pragma unroll
      for (int r = 0; r < 4; ++r) wsf[32 + qb_ + r] = ol4[r]; }
    asm volatile("s_waitcnt lgkmcnt(0)" ::: "memory"); }
  else if constexpr (!RSM) { auto rr = __builtin_amdgcn_permlane32_swap(__float_as_uint(l_reg), __float_as_uint(l_reg), false, false); l_reg = __uint_as_float(rr[0]) + __uint_as_float(rr[1]);
    if (hi == 0) wsf[32 + r32] = l_reg; asm volatile("s_waitcnt lgkmcnt(0)" ::: "memory"); }
  #pragma unroll
  for (int r = 0; r < 16; ++r) { const float l = RSM ? ol[r] : wsf[32 + crow(r, hi)]; bad |= !(l > 1e-30f && l < 1e30f); rli[r] = __builtin_amdgcn_rcpf(l); }
  if (__any(bad)) { if (lane == 0) flag[0] = 1u; }
  if (!MODEA) {
    asm volatile("s_waitcnt lgkmcnt(0)\n\ts_barrier" ::: "memory");
    const bool fb = flag[0] != 0u;
    if (!fb) {
      bf16* Ow = AO + (rowbase + qw0) * 1024 + 512 + h * 64;
      __attribute__((address_space(3))) bf16* stg = (__attribute__((address_space(3))) bf16*)(shm3 + LDS_OST) + wid * 4096;
      #pragma unroll
      for (int r = 0; r < 16; ++r) { const int orow = crow(r, hi);
        #pragma unroll
        for (int d0 = 0; d0 < 2; ++d0) stg[orow * 64 + d0 * 32 + r32] = (bf16)(cvtpk_s(o[d0][r] * rli[r], 0.f) & 0xffffu); }
      asm volatile("s_waitcnt lgkmcnt(0)" ::: "memory");
      #pragma unroll
      for (int i = 0; i < 4; ++i) { const int row = i * 8 + (lane >> 3), ch = lane & 7; const u32x4 v = *(const __attribute__((address_space(3))) u32x4*)(stg + row * 64 + ch * 8); *(u32x4*)(Ow + (long)row * 1024 + ch * 8) = v; }
    }
    asm volatile("s_waitcnt lgkmcnt(0)\n\ts_barrier" ::: "memory");
    if (fb) attn_unit_simple<MODEA>(b, h, qb, QKV, AO, shm, bias_tab, lam, subln);
  } else {
    lds_fptr stg = (lds_fptr)(shm3 + LDS_OST) + wid * 2048;
    #pragma unroll
    for (int r = 0; r < 16; ++r) { const int orow = crow(r, hi);
      #pragma unroll
      for (int d0 = 0; d0 < 2; ++d0) stg[orow * 64 + d0 * 32 + r32] = o[d0][r] * rli[r]; }
    asm volatile("s_waitcnt lgkmcnt(0)\n\ts_barrier" ::: "memory");
    const bool fb = flag[0] != 0u;
    if (!fb) {
      const lds_fptr s1 = (lds_fptr)(shm3 + LDS_OST) + w4 * 2048, s2 = s1 + 4 * 2048;
      bf16* Ow = AO + (rowbase + q0 + 32 * w4) * 1024 + h * 64;
      #pragma unroll
      for (int i = 0; i < 2; ++i) {
        const int row = 16 * part + i * 8 + (lane >> 3), ch = lane & 7;
        const f32x4 a0 = *(const __attribute__((address_space(3))) f32x4*)(s1 + row * 64 + ch * 8), a1 = *(const __attribute__((address_space(3))) f32x4*)(s1 + row * 64 + ch * 8 + 4);
        const f32x4 b0 = *(const __attribute__((address_space(3))) f32x4*)(s2 + row * 64 + ch * 8), b1 = *(const __attribute__((address_space(3))) f32x4*)(s2 + row * 64 + ch * 8 + 4);
        const f32x4 d0v = a0 - b0 * lam, d1v = a1 - b1 * lam;
        float q = ((d0v[0] * d0v[0] + d0v[1] * d0v[1]) + (d0v[2] * d0v[2] + d0v[3] * d0v[3])) + ((d1v[0] * d1v[0] + d1v[1] * d1v[1]) + (d1v[2] * d1v[2] + d1v[3] * d1v[3]));
        q += __shfl_xor(q, 1); q += __shfl_xor(q, 2); q += __shfl_xor(q, 4);
        const float rs = rsqrtf(q * (1.0f / 64.0f) + 1e-6f) * 0.8f;
        const f32x4 g0 = *(const f32x4*)(subln + ch * 8), g1 = *(const f32x4*)(subln + ch * 8 + 4);
        const f32x4 y0 = d0v * rs * g0, y1 = d1v * rs * g1;
        u32x4 w; w.x = cvtpk_s(y0[0], y0[1]); w.y = cvtpk_s(y0[2], y0[3]); w.z = cvtpk_s(y1[0], y1[1]); w.w = cvtpk_s(y1[2], y1[3]);
        *(u32x4*)(Ow + (long)row * 1024 + ch * 8) = w;
      }
    }
    asm volatile("s_waitcnt lgkmcnt(0)\n\ts_barrier" ::: "memory");
    if (fb) attn_unit_simple<MODEA>(b, h, qb, QKV, AO, shm, bias_tab, lam, subln);
  }
  #undef DMA_K
  #undef DMA_V
  #undef BIAS
  #undef REGION
  #undef ROT
}
#undef ATT_WAIT_BAR
#undef ATT_MFMA
#undef ATT_SBAR
}
#define LAS __attribute__((address_space(3)))
#define XB_TMO      128
#define XB_XCNT(j)  (256  + 64 * (j))
#define XB_XSUB(j)  (1280 + 64 * (j))
#define XB_XGEN(j)  (2304 + 64 * (j))
#define XB_TOP      3328
#define XB_TOPGEN   3392
#define XCD_BAR_WORDS 3456
#define XB_SPIN_CAP (1u << 18)

__device__ __forceinline__ unsigned xb_ld(unsigned* p)              { return __hip_atomic_load(p, __ATOMIC_RELAXED, __HIP_MEMORY_SCOPE_AGENT); }
__device__ __forceinline__ unsigned xb_add(unsigned* p, unsigned v) { return __hip_atomic_fetch_add(p, v, __ATOMIC_RELAXED, __HIP_MEMORY_SCOPE_AGENT); }
__device__ __forceinline__ unsigned xb_xcc_id() { return (unsigned)__builtin_amdgcn_s_getreg((3 << 11) | 20) & 0xFu; }
#define XB_SPIN(cond, bar) do { unsigned _sp = 0; while (cond) { __builtin_amdgcn_s_sleep(1); \
    if ((++_sp & 255u) == 0u) { if (xb_ld(&(bar)[XB_TMO])) break; if (_sp > XB_SPIN_CAP) { atomicAdd(&(bar)[XB_TMO], 1u); break; } } } } while (0)

struct XcdBarrier {
    unsigned* bar; unsigned x;
    volatile LAS unsigned* st;
};

__device__ __forceinline__ XcdBarrier xcd_barrier_post(unsigned* bar, volatile LAS unsigned* st) {
    XcdBarrier b; b.bar = bar; b.x = xb_xcc_id(); b.st = st;
    if (threadIdx.x == 0) (void)xb_add(&bar[XB_XCNT(b.x)], 1u);
    return b;
}
__device__ __forceinline__ void xcd_barrier_complete(unsigned* bar, unsigned x, unsigned& nloc, unsigned& nx) {
    const unsigned G = gridDim.x * gridDim.y * gridDim.z;
    unsigned sum, cnt, mine, sp = 0u;
    for (;;) {
        sum = 0u; cnt = 0u; mine = 0u;
#pragma unroll
        for (unsigned j = 0; j < 16; ++j) { const unsigned c = xb_ld(&bar[XB_XCNT(j)]); sum += c; cnt += (c > 0u) ? 1u : 0u; mine = (j == x) ? c : mine; }
        if (sum == G) break;
        __builtin_amdgcn_s_sleep(1);
        if ((++sp & 255u) == 0u) { if (xb_ld(&bar[XB_TMO])) break; if (sp > XB_SPIN_CAP) { atomicAdd(&bar[XB_TMO], 1u); break; } }
    }
    nloc = mine > 0u ? mine : 1u; nx = cnt > 0u ? cnt : 1u;
}

__device__ __forceinline__ void xcd_barrier(const XcdBarrier& b) {
    asm volatile("s_waitcnt vmcnt(0)" ::: "memory");
    __syncthreads();
    if (threadIdx.x == 0) {
        unsigned* bar = b.bar;
        __builtin_amdgcn_s_waitcnt(0);
        unsigned nloc = b.st[0], nx = b.st[1];
        if (nloc == 0u) { xcd_barrier_complete(bar, b.x, nloc, nx); b.st[0] = nloc; b.st[1] = nx; }
        const unsigned old = xb_add(&bar[XB_XSUB(b.x)], 1u);
        const unsigned gen = old / nloc;
        if (old + 1u == (gen + 1u) * nloc) {
            __builtin_amdgcn_fence(__ATOMIC_RELEASE, "agent");
            asm volatile("s_waitcnt vmcnt(0)" ::: "memory");
            const unsigned og = xb_add(&bar[XB_TOP], 1u);
            const unsigned tg = og / nx;
            if (og + 1u == (tg + 1u) * nx) xb_add(&bar[XB_TOPGEN], 1u);
            else XB_SPIN(xb_ld(&bar[XB_TOPGEN]) == tg, bar);
            __builtin_amdgcn_fence(__ATOMIC_ACQUIRE, "agent");
            xb_add(&bar[XB_XGEN(b.x)], 1u);
            asm volatile("s_waitcnt vmcnt(0)" ::: "memory");
        } else {
            XB_SPIN(xb_ld(&bar[XB_XGEN(b.x)]) == gen, bar);
            __builtin_amdgcn_fence(__ATOMIC_ACQUIRE, "agent");
            asm volatile("s_waitcnt vmcnt(0)" ::: "memory");
        }
    }
    __syncthreads();
}
constexpr int NWAVES = 8;
constexpr int BATCH = 8, SEQ = 4096, D = 1024, FF = 2816, DIN = 2304, M = BATCH * SEQ;
constexpr int NPH = 9;
constexpr size_t MiB = 1u << 20;
constexpr size_t WS_CTL = 0, CTL_ZERO_BYTES = 1 * MiB;
constexpr size_t WS_TAB = 1 * MiB;
constexpr size_t TAB_CS = 256, TAB_BIAS = 256 + 8192;
constexpr int CW_BAR = 4096;
constexpr int CW_SBMAX = CW_BAR + 3456;
constexpr int ZERO_WORDS = 3456;
constexpr size_t TAB_R1 = 32768, TAB_R2 = 32768 + 131072, TAB_SB = 32768 + 2 * 131072;
constexpr size_t WS_AM2 = 6 * MiB;
constexpr size_t WS_SS1 = 2 * MiB, WS_SS2 = 4 * MiB;
constexpr size_t WS_W1GU = 8 * MiB, WS_W1D = 20 * MiB, WS_WIN = 26 * MiB, WS_WOUT = 31 * MiB, WS_W2GU = 34 * MiB, WS_W2D = 46 * MiB;
constexpr size_t WS_A = 56 * MiB;
constexpr size_t WS_B = 232 * MiB;
constexpr size_t WS_C = 296 * MiB;
constexpr size_t WS_D = 360 * MiB;
constexpr size_t WS_END = 424 * MiB;
static_assert(WS_W1GU + (size_t)2 * FF * D * 2 <= WS_W1D && WS_W1D + (size_t)FF * D * 2 <= WS_WIN && WS_WIN + (size_t)DIN * D * 2 <= WS_WOUT && WS_WOUT + (size_t)D * D * 2 <= WS_W2GU &&
              WS_W2GU + (size_t)2 * FF * D * 2 <= WS_W2D && WS_W2D + (size_t)FF * D * 2 <= WS_A && WS_A + (size_t)M * FF * 2 <= WS_B && WS_AM2 + (size_t)M * 64 <= WS_W1GU && TAB_SB + (2 * 5632 + 2304) * 4 <= MiB, "d_ws map");
constexpr int RING_OFF = 0, RING_BYTES = 131072;
constexpr int LDSCTL_OFF = RING_BYTES, MISC_OFF = LDSCTL_OFF + 320;
constexpr int LDS_BYTES = 147456;
static_assert(att::LDS_BYTES <= RING_BYTES, "attention scratch fits the ring region");

#define GAS __attribute__((address_space(1)))
typedef unsigned short bf16;
typedef unsigned v4u __attribute__((ext_vector_type(4)));
typedef float f32x4 __attribute__((ext_vector_type(4)));
#define LDS_WAIT() asm volatile("s_waitcnt lgkmcnt(0)" ::: "memory")
__device__ __forceinline__ unsigned f2bf(float f) { unsigned u = __builtin_bit_cast(unsigned, f); return (u + 0x7fffu + ((u >> 16) & 1u)) >> 16; }
__device__ __forceinline__ unsigned pk2(float lo, float hi) { return pg8::cvt_pk_bf16(lo, hi); }
__device__ __forceinline__ float wave_sum(float v) {
#pragma unroll
    for (int o = 1; o < 64; o <<= 1) v += __shfl_xor(v, o);
    return v;
}

__device__ __forceinline__ void p0_tr_load(const float* W, int N, int k0, int n0, f32x4 (&v)[8], int lane) {
    const int kk8 = lane >> 3, n4 = (lane & 7) * 4;
#pragma unroll
    for (int i = 0; i < 8; ++i) v[i] = *(const GAS f32x4*)(W + (size_t)(k0 + i * 8 + kk8) * N + n0 + n4);
}
template <bool BLKD>
__device__ __forceinline__ void p0_tr_emit(const f32x4 (&v)[8], int K, bf16* WT, int k0, int drow0, LAS float* scr, int lane) {
    const int kk8 = lane >> 3, n4 = (lane & 7) * 4;
#pragma unroll
    for (int i = 0; i < 8; ++i) { const int kk = i * 8 + kk8; LAS float* s = scr + kk * 33 + n4; s[0] = v[i].x; s[1] = v[i].y; s[2] = v[i].z; s[3] = v[i].w; }
    LDS_WAIT(); asm volatile("" ::: "memory");
    const int c = lane & 7;
#pragma unroll
    for (int j = 0; j < 4; ++j) { const int n = (lane >> 3) + 8 * j; const LAS float* s = scr + (8 * c) * 33 + n;
        v4u o; o.x = pk2(s[0 * 33], s[1 * 33]); o.y = pk2(s[2 * 33], s[3 * 33]); o.z = pk2(s[4 * 33], s[5 * 33]); o.w = pk2(s[6 * 33], s[7 * 33]);
        const int dr = drow0 + n;
        if constexpr (BLKD) *(GAS v4u*)(WT + (((size_t)(dr >> 8) * (K / 64) + (k0 >> 6)) * 256 + (dr & 255)) * 64 + 8 * c) = o;
        else *(GAS v4u*)(WT + (size_t)dr * K + k0 + 8 * c) = o; }
    LDS_WAIT(); asm volatile("" ::: "memory");
}

__device__ __forceinline__ float wave_max(float v) {
#pragma unroll
    for (int o = 1; o < 64; o <<= 1) v = fmaxf(v, __shfl_xor(v, o));
    return v;
}
__device__ __forceinline__ unsigned pack4i8(int a, int b, int c, int d) { return ((unsigned)a & 0xffu) | (((unsigned)b & 0xffu) << 8) | (((unsigned)c & 0xffu) << 16) | ((unsigned)d << 24); }
__device__ __forceinline__ unsigned quant4(f32x4 v, float inv) { const f32x4 q = v * inv; return pack4i8((int)__builtin_rintf(q.x), (int)__builtin_rintf(q.y), (int)__builtin_rintf(q.z), (int)__builtin_rintf(q.w)); }
__device__ __forceinline__ void p0_quant_regs(const f32x4 (&v)[8], int K, signed char* W8, int k0, int drow0, const float* g, f32x4 inv, LAS float* scr, int lane) {
    const int kk8 = lane >> 3, n4 = (lane & 7) * 4;
    LAS int* si = (LAS int*)scr;
#pragma unroll
    for (int i = 0; i < 8; ++i) { const int kk = i * 8 + kk8; const float gg = g[k0 + kk]; const f32x4 q = v[i] * gg * inv; LAS int* s = si + kk * 33 + n4;
        s[0] = (int)__builtin_rintf(q.x); s[1] = (int)__builtin_rintf(q.y); s[2] = (int)__builtin_rintf(q.z); s[3] = (int)__builtin_rintf(q.w); }
    LDS_WAIT(); asm volatile("" ::: "memory");
    const int n = lane >> 1, h = lane & 1; const LAS int* s = si + (32 * h) * 33 + n;
    v4u o0, o1;
    o0.x = pack4i8(s[0 * 33], s[1 * 33], s[2 * 33], s[3 * 33]);     o0.y = pack4i8(s[4 * 33], s[5 * 33], s[6 * 33], s[7 * 33]);
    o0.z = pack4i8(s[8 * 33], s[9 * 33], s[10 * 33], s[11 * 33]);   o0.w = pack4i8(s[12 * 33], s[13 * 33], s[14 * 33], s[15 * 33]);
    o1.x = pack4i8(s[16 * 33], s[17 * 33], s[18 * 33], s[19 * 33]); o1.y = pack4i8(s[20 * 33], s[21 * 33], s[22 * 33], s[23 * 33]);
    o1.z = pack4i8(s[24 * 33], s[25 * 33], s[26 * 33], s[27 * 33]); o1.w = pack4i8(s[28 * 33], s[29 * 33], s[30 * 33], s[31 * 33]);
    GAS v4u* dst = (GAS v4u*)(W8 + (size_t)(drow0 + n) * K + k0 + 32 * h);
    dst[0] = o0; dst[1] = o1;
    LDS_WAIT(); asm volatile("" ::: "memory");
}
__device__ __forceinline__ void quant_row_store(signed char* dst, const f32x4 (&v)[4], float inv, int lane) {
    GAS unsigned* d = (GAS unsigned*)dst + lane;
#pragma unroll
    for (int j = 0; j < 4; ++j) d[64 * j] = quant4(v[j], inv);
}

__device__ __forceinline__ void requant_rows(const bf16* Xsrc, const float* ssp, const float* amp, signed char* q8, float* Rr, int gw, int NGW, int lane) {
    constexpr int QR = 8;
    for (int m0 = QR * gw; m0 < M; m0 += QR * NGW) {
        unsigned long long w[QR][4]; float sv[QR], av[QR];
#pragma unroll
        for (int r = 0; r < QR; ++r) { const GAS unsigned long long* xr = (const GAS unsigned long long*)(Xsrc + (size_t)(m0 + r) * D) + lane;
#pragma unroll
            for (int j = 0; j < 4; ++j) w[r][j] = xr[64 * j];
            sv[r] = lane < 16 ? ssp[(size_t)(m0 + r) * 16 + lane] : 0.f; av[r] = lane < 16 ? amp[(size_t)(m0 + r) * 16 + lane] : 0.f; }
#pragma unroll
        for (int r = 0; r < QR; ++r) { const float s = wave_sum(sv[r]), a = wave_max(av[r]);
            f32x4 v[4];
#pragma unroll
            for (int j = 0; j < 4; ++j) v[j] = pg8::bf16lo4((unsigned)w[r][j], (unsigned)(w[r][j] >> 32));
            quant_row_store(q8 + (size_t)(m0 + r) * D, v, a > 0.f ? 127.0f / a : 0.f, lane);
            if (lane == 0) Rr[m0 + r] = a * (1.0f / 127.0f) * rsqrtf(s * (1.f / D) + 1e-6f); }
    }
}

struct Args { const float* in[21]; float* out; unsigned char* ws; int ph_lo, ph_hi; };

__device__ __forceinline__ int t5_bucket(int rel) {
    const int n = rel < 0 ? -rel : rel; int bk;
    if (n < 8) bk = n; else { const int l = 2 + (31 - __clz(n * n)); bk = l < 15 ? l : 15; }
    return bk + (rel > 0 ? 16 : 0);
}

__global__ void __launch_bounds__(NWAVES * 64, 2) mega_fwd(Args args) {
    extern __shared__ __attribute__((aligned(16))) unsigned char lds[];
    LAS unsigned char* ldsp = (LAS unsigned char*)lds;
    volatile LAS unsigned* MISC = (volatile LAS unsigned*)(ldsp + MISC_OFF);
    const int tid = threadIdx.x, lane = tid & 63, wave = __builtin_amdgcn_readfirstlane(tid >> 6);
    const int G = gridDim.x; const int bx = blockIdx.x; const int vcu = (G % 8 == 0) ? (bx % 8) * (G / 8) + bx / 8 : bx;
    unsigned char* ws = args.ws;
    unsigned* ctl = (unsigned*)(ws + WS_CTL);
    const float* x = args.in[0];
    float* out = args.out;
    float* misc = (float*)(ws + WS_TAB); float* cs = misc + TAB_CS / 4; float* bias_tab = misc + TAB_BIAS / 4;
    float* ss1 = (float*)(ws + WS_SS1); float* ss2 = (float*)(ws + WS_SS2); float* ss3 = ss1; float* am2 = (float*)(ws + WS_AM2);
    float* R1 = (float*)(ws + WS_TAB + TAB_R1); float* R2 = (float*)(ws + WS_TAB + TAB_R2); float* sbw = (float*)(ws + WS_TAB + TAB_SB);
    signed char* Win8 = (signed char*)(ws + WS_WIN); signed char* A3q = (signed char*)(ws + WS_D); float* R3 = R1; float* am1 = am2;
    signed char* W1gu8 = (signed char*)(ws + WS_W1GU); signed char* W2gu8 = (signed char*)(ws + WS_W2GU); signed char* A1q = (signed char*)(ws + WS_D); signed char* A2q = (signed char*)(ws + WS_D);
    bf16* W1gu = (bf16*)(ws + WS_W1GU); bf16* W1d = (bf16*)(ws + WS_W1D); bf16* WinT = (bf16*)(ws + WS_WIN); bf16* WoutT = (bf16*)(ws + WS_WOUT); bf16* W2gu = (bf16*)(ws + WS_W2GU); bf16* W2d = (bf16*)(ws + WS_W2D);
    bf16* ACT = (bf16*)(ws + WS_A); bf16* QKV = (bf16*)(ws + WS_A);
    bf16* Xb = (bf16*)(ws + WS_B); bf16* X2b = (bf16*)(ws + WS_B); bf16* X1b = (bf16*)(ws + WS_C); bf16* X3b = (bf16*)(ws + WS_C); bf16* AO = (bf16*)(ws + WS_D);
    for (int u = tid; u < (LDS_BYTES - LDSCTL_OFF) / 4; u += NWAVES * 64) ((LAS unsigned*)(ldsp + LDSCTL_OFF))[u] = 0u;
    __syncthreads();
    XcdBarrier bar = xcd_barrier_post(ctl + CW_BAR, MISC + 8);
    const int lo = args.ph_lo, hi = args.ph_hi;
#define IN(k) (lo <= (k) && (k) < hi)
#define SEAM(k) do { if (IN(k) && IN((k) + 1)) xcd_barrier(bar); } while (0)
    const int gw = vcu * NWAVES + wave, NGW = G * NWAVES;
#ifdef PROBE_TS
    unsigned long long ts_a_ = 0, ts_b_ = 0;
#if PROBE_TS == 100
#define TS_MARK(k) do { if ((k) == 0) ts_a_ = __builtin_amdgcn_s_memrealtime(); if ((k) == 9) ts_b_ = __builtin_amdgcn_s_memrealtime(); } while (0)
#else
#define TS_MARK(k) do { if ((k) == PROBE_TS) ts_a_ = __builtin_amdgcn_s_memrealtime(); if ((k) == PROBE_TS + 1) ts_b_ = __builtin_amdgcn_s_memrealtime(); } while (0)
#endif
#else
#define TS_MARK(k) do { } while (0)
#endif
    TS_MARK(0);

    if (IN(0)) {
        LAS float* scr = (LAS float*)(ldsp + RING_OFF + wave * 16384);
        constexpr int I_GU = (D / 64) * (FF / 32), I_DN = (FF / 64) * (D / 32), I_IN = (D / 64) * (DIN / 32), I_OUT = (D / 64) * (D / 32);
        constexpr int NSTRIP_GU = 4 * (FF / 32), NSTRIP = NSTRIP_GU + DIN / 32;
        const int nhw = 2 * G, hw = 2 * vcu + (wave >> 2), w4 = wave & 3;
        LAS float* cm = (LAS float*)(ldsp + RING_OFF + 12288);
        for (int s0 = 0; s0 < NSTRIP; s0 += nhw) {
            const int strip = s0 + hw; const bool valid = strip < NSTRIP;
            const bool isin = valid && strip >= NSTRIP_GU;
            const int which = (valid && !isin) ? strip / (FF / 32) : 0, nb = !valid ? 0 : isin ? strip - NSTRIP_GU : strip % (FF / 32), n0 = 32 * nb;
            const float* W = isin ? args.in[6] : args.in[which == 0 ? 2 : which == 1 ? 3 : which == 2 ? 17 : 18]; const float* gn = isin ? args.in[5] : args.in[which < 2 ? 1 : 16];
            const int NW = isin ? DIN : FF;
            const int drow0 = isin ? 256 * (n0 / 256) + 128 * ((n0 % 64) / 32) + 32 * ((n0 % 256) / 64) : 256 * (n0 / 128) + 128 * (which & 1) + (n0 % 128);
            signed char* W8 = isin ? Win8 : (which < 2 ? W1gu8 : W2gu8); float* sbo = isin ? sbw + 2 * 5632 : sbw + (which >> 1) * 5632;
            const int kk8 = lane >> 3, n4 = (lane & 7) * 4;
            f32x4 v[2][8]; f32x4 mloc = {0.f, 0.f, 0.f, 0.f};
#define P0_LOAD2(q0) do { _Pragma("unroll") for (int q = 0; q < 2; ++q) _Pragma("unroll") for (int i = 0; i < 8; ++i) v[q][i] = *(const GAS f32x4*)(W + (size_t)(64 * (4 * w4 + (q0) + q) + i * 8 + kk8) * NW + n0 + n4); } while (0)
#define P0_MAX2(q0) do { _Pragma("unroll") for (int q = 0; q < 2; ++q) _Pragma("unroll") for (int i = 0; i < 8; ++i) { const float gg = gn[64 * (4 * w4 + (q0) + q) + i * 8 + kk8]; const f32x4 a = __builtin_elementwise_abs(v[q][i] * gg); \
                        mloc.x = fmaxf(mloc.x, a.x); mloc.y = fmaxf(mloc.y, a.y); mloc.z = fmaxf(mloc.z, a.z); mloc.w = fmaxf(mloc.w, a.w); } } while (0)
            if (valid) {
                P0_LOAD2(0); P0_MAX2(0); asm volatile("" ::: "memory"); P0_LOAD2(2); P0_MAX2(2);
#pragma unroll
                for (int o = 8; o < 64; o <<= 1) { mloc.x = fmaxf(mloc.x, __shfl_xor(mloc.x, o)); mloc.y = fmaxf(mloc.y, __shfl_xor(mloc.y, o)); mloc.z = fmaxf(mloc.z, __shfl_xor(mloc.z, o)); mloc.w = fmaxf(mloc.w, __shfl_xor(mloc.w, o)); }
                if (lane < 8) *(LAS f32x4*)(cm + ((wave >> 2) * 4 + w4) * 32 + n4) = mloc;
            }
            __syncthreads();
            if (valid) {
                f32x4 mx = *(const LAS f32x4*)(cm + ((wave >> 2) * 4 + 0) * 32 + n4);
#pragma unroll
                for (int j = 1; j < 4; ++j) { const f32x4 t = *(const LAS f32x4*)(cm + ((wave >> 2) * 4 + j) * 32 + n4); mx.x = fmaxf(mx.x, t.x); mx.y = fmaxf(mx.y, t.y); mx.z = fmaxf(mx.z, t.z); mx.w = fmaxf(mx.w, t.w); }
                f32x4 inv; inv.x = mx.x > 0.f ? 127.0f / mx.x : 0.f; inv.y = mx.y > 0.f ? 127.0f / mx.y : 0.f; inv.z = mx.z > 0.f ? 127.0f / mx.z : 0.f; inv.w = mx.w > 0.f ? 127.0f / mx.w : 0.f;
                if (w4 == 0 && lane < 8) *(f32x4*)(sbo + drow0 + n4) = mx * (1.0f / 127.0f);
                p0_quant_regs(v[0], D, W8, 64 * (4 * w4 + 2), drow0, gn, inv, scr, lane); p0_quant_regs(v[1], D, W8, 64 * (4 * w4 + 3), drow0, gn, inv, scr, lane);
                P0_LOAD2(0);
                p0_quant_regs(v[0], D, W8, 64 * (4 * w4 + 0), drow0, gn, inv, scr, lane); p0_quant_regs(v[1], D, W8, 64 * (4 * w4 + 1), drow0, gn, inv, scr, lane);
            }
            __syncthreads();
#undef P0_LOAD2
#undef P0_MAX2
        }
        constexpr int NITEMS = 2 * I_DN + I_OUT;
        int it_lo, it_hi, it_step;
        if (nhw >= NSTRIP && NSTRIP * 4 + (nhw - NSTRIP) * 4 * 5 >= NITEMS) { if (hw < NSTRIP) { it_lo = hw * 4 + w4; it_hi = it_lo + 1; } else { it_lo = NSTRIP * 4 + ((hw - NSTRIP) * 4 + w4) * 5; it_hi = it_lo + 5; } it_step = 1; if (it_hi > NITEMS) it_hi = NITEMS; }
        else { it_lo = gw; it_hi = NITEMS; it_step = NGW; }
#define P0_ITEM_LOAD(it_, vv) do { int r = (it_); if (r < 2 * I_DN) { const int which = r / I_DN; r -= which * I_DN; const int nblk = D / 32, kb = r / nblk, nb = r % nblk; p0_tr_load(args.in[which ? 19 : 4], D, 64 * kb, 32 * nb, vv, lane); } \
            else { r -= 2 * I_DN; const int nblk = D / 32, kb = r / nblk, nb = r % nblk; p0_tr_load(args.in[15], D, 64 * kb, 32 * nb, vv, lane); } } while (0)
#define P0_ITEM_EMIT(it_, vv) do { int r = (it_); if (r < 2 * I_DN) { const int which = r / I_DN; r -= which * I_DN; const int nblk = D / 32, kb = r / nblk, nb = r % nblk; p0_tr_emit<true>(vv, FF, which ? W2d : W1d, 64 * kb, 32 * nb, scr, lane); } \
            else { r -= 2 * I_DN; const int nblk = D / 32, kb = r / nblk, nb = r % nblk; p0_tr_emit<false>(vv, D, WoutT, 64 * kb, 32 * nb, scr, lane); } } while (0)
        { f32x4 va[8], vb[8];
          if (it_lo < it_hi) P0_ITEM_LOAD(it_lo, va);
          for (int it = it_lo; it < it_hi; it += 2 * it_step) {
              if (it + it_step < it_hi) P0_ITEM_LOAD(it + it_step, vb);
              P0_ITEM_EMIT(it, va);
              if (it + it_step < it_hi) { if (it + 2 * it_step < it_hi) P0_ITEM_LOAD(it + 2 * it_step, va); P0_ITEM_EMIT(it + it_step, vb); }
          } }
#undef P0_ITEM_LOAD
#undef P0_ITEM_EMIT
        { const int gt = vcu * NWAVES * 64 + tid;
          if (gt < 1024) { const int pos = gt >> 4, fi = gt & 15; const float inv = powf(10000.0f, -(float)fi / 16.0f); const float ang = (float)pos * inv; cs[2 * gt] = cosf(ang); cs[2 * gt + 1] = sinf(ang); }
          else if (gt < 1024 + 8 * att::TBL_N) { const int i = gt - 1024, h = i / att::TBL_N, rel = i % att::TBL_N - att::TBL_OFF; bias_tab[i] = args.in[14][t5_bucket(rel) * 8 + h] * 1.4426950408889634f; }
          else if (gt == 1024 + 8 * att::TBL_N) { float s1 = 0.f, s2 = 0.f; for (int d = 0; d < 32; ++d) { s1 += args.in[7][d] * args.in[8][d]; s2 += args.in[9][d] * args.in[10][d]; } misc[0] = expf(s1) - expf(s2) + 0.2f; } }
        constexpr int XR = 8;
        for (int m0 = XR * gw; m0 < M; m0 += XR * NGW) {
            f32x4 v[XR][4];
#pragma unroll
            for (int r = 0; r < XR; ++r) { const GAS f32x4* xr = (const GAS f32x4*)(x + (size_t)(m0 + r) * D) + lane;
#pragma unroll
                for (int j = 0; j < 4; ++j) v[r][j] = __builtin_nontemporal_load(xr + 64 * j); }
#pragma unroll
            for (int r = 0; r < XR; ++r) { float s = 0.f, a = 0.f;
#pragma unroll
                for (int j = 0; j < 4; ++j) { s += (v[r][j].x * v[r][j].x + v[r][j].y * v[r][j].y) + (v[r][j].z * v[r][j].z + v[r][j].w * v[r][j].w);
                    a = fmaxf(a, fmaxf(fmaxf(fabsf(v[r][j].x), fabsf(v[r][j].y)), fmaxf(fabsf(v[r][j].z), fabsf(v[r][j].w)))); }
                s = wave_sum(s); a = wave_max(a);
                GAS unsigned long long* o8 = (GAS unsigned long long*)(Xb + (size_t)(m0 + r) * D) + lane;
#pragma unroll
                for (int j = 0; j < 4; ++j) o8[64 * j] = (unsigned long long)pk2(v[r][j].x, v[r][j].y) | ((unsigned long long)pk2(v[r][j].z, v[r][j].w) << 32);
                quant_row_store(A1q + (size_t)(m0 + r) * D, v[r], a > 0.f ? 127.0f / a : 0.f, lane);
                if (lane == 0) R1[m0 + r] = a * (1.0f / 127.0f) * rsqrtf(s * (1.f / D) + 1e-6f); }
        }
    }
    SEAM(0); TS_MARK(1);
    if (IN(1)) { pg8::Gemm g{(const bf16*)A1q, (const bf16*)W1gu8, M, 2 * FF, D / 2}; pg8::StaticOrder S; S.init(M, 2 * FF, G, bx); pg8::EpiSwiGLU8<true> E{ACT, FF, R1, sbw};
        pg8::gemm_phase<pg8::EpiSwiGLU8<true>, pg8::StaticOrder, true, true>(ldsp + RING_OFF, g, S, E); }
    SEAM(1); TS_MARK(2);
    if (IN(2)) { pg8::Gemm g{ACT, W1d, M, D, FF}; pg8::StaticOrder S; S.init(M, D, G, bx); pg8::EpiResid<true> E{Xb, X1b, ss1, 0.5f, am1};
        pg8::gemm_phase<pg8::EpiResid<true>, pg8::StaticOrder, true, true, true>(ldsp + RING_OFF, g, S, E); }
    SEAM(2); TS_MARK(3);
    if (IN(3)) {
        requant_rows(X1b, ss1, am1, A3q, R3, gw, NGW, lane);
        xcd_barrier(bar);
        pg8::Gemm g{(const bf16*)A3q, (const bf16*)Win8, M, DIN, D / 2}; pg8::StaticOrder S; S.init(M, DIN, G, bx); pg8::EpiProjT<true> E{QKV, R3, args.in[12], args.in[13], cs, sbw + 2 * 5632};
        pg8::gemm_phase<pg8::EpiProjT<true>, pg8::StaticOrder, true, true>(ldsp + RING_OFF, g, S, E); }
    SEAM(3); TS_MARK(4);
#ifdef PROBE_IDLE
    { const unsigned long long t0_ = __builtin_amdgcn_s_memrealtime(); while (__builtin_amdgcn_s_memrealtime() - t0_ < (unsigned long long)(PROBE_IDLE)) __builtin_amdgcn_s_sleep(16); }
#endif
    if (IN(4)) {
        const float lam = misc[0];
        { const int NU = BATCH * 8 * 32, upc = (NU + G - 1) / G;
          for (int i = 0; i < upc; ++i) { const int u = vcu * upc + i; if (u >= NU) break; const int bh = u >> 5, qb = u & 31;
              att::attn_unit<true>(bh >> 3, bh & 7, qb, QKV, AO, (char*)lds + RING_OFF, bias_tab, lam, args.in[11]); } }
        { const int NU = BATCH * 8 * 16, upc = (NU + G - 1) / G;
          for (int i = 0; i < upc; ++i) { const int u = vcu * upc + i; if (u >= NU) break; const int bh = u >> 4, qb = u & 15;
              att::attn_unit<false>(bh >> 3, bh & 7, qb, QKV, AO, (char*)lds + RING_OFF, bias_tab, lam, args.in[11]); } }
    }
#ifdef PROBE_XBAR
    if (IN(4)) for (int i_ = 0; i_ < PROBE_XBAR; ++i_) xcd_barrier(bar);
#endif
    SEAM(4); TS_MARK(5);
    if (IN(5)) { pg8::Gemm g{AO, WoutT, M, D, D}; pg8::StaticOrder S; S.init(M, D, G, bx); pg8::EpiResid<true> E{X1b, X2b, ss2, 1.0f, am2};
        pg8::gemm_phase<pg8::EpiResid<true>, pg8::StaticOrder, true, true>(ldsp + RING_OFF, g, S, E); }
    SEAM(5); TS_MARK(6);
    if (IN(6)) {
        requant_rows(X2b, ss2, am2, A2q, R2, gw, NGW, lane);
        xcd_barrier(bar);
        pg8::Gemm g{(const bf16*)A2q, (const bf16*)W2gu8, M, 2 * FF, D / 2}; pg8::StaticOrder S; S.init(M, 2 * FF, G, bx); pg8::EpiSwiGLU8<true> E{ACT, FF, R2, sbw + 5632};
        pg8::gemm_phase<pg8::EpiSwiGLU8<true>, pg8::StaticOrder, true, true>(ldsp + RING_OFF, g, S, E); }
    SEAM(6); TS_MARK(7);
    if (IN(7)) { pg8::Gemm g{ACT, W2d, M, D, FF}; pg8::StaticOrder S; S.init(M, D, G, bx); pg8::EpiResid<false> E{X2b, X3b, ss3, 0.5f, nullptr};
        pg8::gemm_phase<pg8::EpiResid<false>, pg8::StaticOrder, true, true, true>(ldsp + RING_OFF, g, S, E); }
    SEAM(7); TS_MARK(8);
    if (IN(8)) {
        const f32x4* gr = (const f32x4*)args.in[20] + lane;
        f32x4 gg[4];
#pragma unroll
        for (int j = 0; j < 4; ++j) gg[j] = gr[64 * j];
        constexpr int FR = 8;
        for (int m0 = FR * gw; m0 < M; m0 += FR * NGW) {
            unsigned long long w[FR][4]; float rstd[FR];
#pragma unroll
            for (int r = 0; r < FR; ++r) { const GAS unsigned long long* xr = (const GAS unsigned long long*)(X3b + (size_t)(m0 + r) * D) + lane;
#pragma unroll
                for (int j = 0; j < 4; ++j) w[r][j] = xr[64 * j];
                rstd[r] = lane < 16 ? ss3[(size_t)(m0 + r) * 16 + lane] : 0.f; }
#pragma unroll
            for (int r = 0; r < FR; ++r) { rstd[r] = rsqrtf(wave_sum(rstd[r]) * (1.f / D) + 1e-6f); GAS f32x4* orow = (GAS f32x4*)(out + (size_t)(m0 + r) * D) + lane;
#pragma unroll
                for (int j = 0; j < 4; ++j) { const f32x4 v = pg8::bf16lo4((unsigned)w[r][j], (unsigned)(w[r][j] >> 32)); __builtin_nontemporal_store(v * rstd[r] * gg[j], orow + 64 * j); } }
        }
    }
#if defined(PROBE_TS) && (PROBE_TS == 8 || PROBE_TS == 100)
    xcd_barrier(bar);
#endif
    TS_MARK(9);
#ifdef PROBE_TS
    if (bx == 0 && wave == 0) { const unsigned long long d_ = ts_b_ - ts_a_, t0_ = __builtin_amdgcn_s_memrealtime(); while (__builtin_amdgcn_s_memrealtime() - t0_ < d_) __builtin_amdgcn_s_sleep(8); }
#endif
#undef IN
#undef SEAM
}

extern "C" void kernel_launch(void* const* d_in, const int* in_sizes, int n_in, void* d_out, int out_size, void* d_ws, size_t ws_size, hipStream_t stream) {
    static int grid = 0;
    if (grid == 0) {
        if (n_in != 21 || in_sizes[0] != M * D || out_size != M * D || ws_size < WS_END) { fprintf(stderr, "kernel_launch: unexpected shapes (n_in %d, in0 %d, out %d, ws %zu)\n", n_in, n_in > 0 ? in_sizes[0] : -1, out_size, ws_size); grid = -1; return; }
        int dev = 0, cus = 0, per_cu = 0;
        if (hipGetDevice(&dev) != hipSuccess || hipDeviceGetAttribute(&cus, hipDeviceAttributeMultiprocessorCount, dev) != hipSuccess) { grid = -1; return; }
        if (hipFuncSetAttribute((const void*)mega_fwd, hipFuncAttributeMaxDynamicSharedMemorySize, LDS_BYTES) != hipSuccess) { fprintf(stderr, "kernel_launch: hipFuncSetAttribute failed\n"); grid = -1; return; }
        if (hipOccupancyMaxActiveBlocksPerMultiprocessor(&per_cu, (const void*)mega_fwd, NWAVES * 64, LDS_BYTES) != hipSuccess || per_cu < 1) { fprintf(stderr, "kernel_launch: occupancy query reports %d workgroups per CU\n", per_cu); (void)hipGetLastError(); grid = -1; return; }
        grid = cus;
    }
    if (grid < 0) return;
    if (hipMemsetAsync((char*)d_ws + WS_CTL + CW_BAR * 4, 0, ZERO_WORDS * 4, stream) != hipSuccess) return;
    Args a{};
    for (int i = 0; i < 21; ++i) a.in[i] = (const float*)d_in[i];
    a.out = (float*)d_out; a.ws = (unsigned char*)d_ws; a.ph_lo = 0; a.ph_hi = NPH;
#ifdef PROBE_SPLIT
    a.ph_hi = PROBE_SPLIT + 1;
    hipLaunchKernelGGL(mega_fwd, dim3(grid), dim3(NWAVES * 64), LDS_BYTES, stream, a);
    if (hipMemsetAsync((char*)d_ws + WS_CTL, 0, CTL_ZERO_BYTES, stream) != hipSuccess) return;
    a.ph_lo = PROBE_SPLIT; a.ph_hi = NPH;
#endif
    hipLaunchKernelGGL(mega_fwd, dim3(grid), dim3(NWAVES * 64), LDS_BYTES, stream, a);
}
```

```cpp
#include <hip/hip_runtime.h>
#include <cstdio>
#include <cstdint>
#include <cmath>
namespace pg8 {
#define PG8_LAS __attribute__((address_space(3)))
typedef unsigned short bf16_t;
typedef short bf16x8 __attribute__((ext_vector_type(8)));
typedef float f32x4 __attribute__((ext_vector_type(4)));
typedef unsigned u32x4 __attribute__((ext_vector_type(4)));
constexpr int BM = 256, BK = 64, HALF = 128, HTB = HALF * BK * 2  , STAGE_BYTES = 8 * HTB, NXCD = 8, WGM = 4;

__host__ __device__ __forceinline__ int lds_byte(int r, int c) { const int st = (r >> 4) * 2 + (c >> 5), rr = r & 15, cc = c & 31, ob = rr * 64 + cc * 2; return st * 1024 + (ob ^ (((ob >> 9) & 1) << 5)); }
__host__ __device__ __forceinline__ void stage_rc(int b, int& R, int& C) { const int st = b / 1024, sb = b % 1024, swz = sb ^ (((sb >> 9) & 1) << 5); R = (st >> 1) * 16 + swz / 64; C = (st & 1) * 32 + (swz % 64) / 2; }
__host__ __device__ __forceinline__ int perm32(int rho) { const int n = rho >> 4, i = rho & 15; return 8 * (i >> 2) + 4 * n + (i & 3); }

struct Unit { int pm, pn; };
struct Gemm { const bf16_t* A; const bf16_t* Bt; int M, N, K; };

struct StaticOrder {
    int nM, nN, nwg, G, c;
    __host__ __device__ void init(int M, int N, int G_, int c_) { nM = M / BM; nN = N / BM; nwg = nM * nN; G = G_; c = c_; }
    __host__ __device__ bool next(int i, Unit& u) const {
        const long L = (long)i * G + c; if (L >= nwg) return false;
        int wgid = (int)L; { const int q = nwg / NXCD, r = nwg % NXCD, xcd = wgid % NXCD, off = wgid / NXCD; wgid = (xcd < r ? xcd * (q + 1) : r * (q + 1) + (xcd - r) * q) + off; }
        const int nig = WGM * nN, gid = wgid / nig, fm = gid * WGM, gsz = (nM - fm) < WGM ? (nM - fm) : WGM;
        u.pm = fm + ((wgid % nig) % gsz); u.pn = (wgid % nig) / gsz; return true;
    }
    __device__ __forceinline__ void a_ready(const Unit&) const {}
    __device__ __forceinline__ void done(const Unit&) const {}
};

__device__ __forceinline__ unsigned cvt_pk_bf16(float lo, float hi) { unsigned r; asm volatile("v_cvt_pk_bf16_f32 %0, %1, %2" : "=v"(r) : "v"(lo), "v"(hi)); return r; }
#define QKV_BSTRIDE 11534336L
constexpr float RMS_EPS = 1e-6f;
typedef int i32x4 __attribute__((ext_vector_type(4)));
template <bool I8> __device__ __forceinline__ f32x4 pg8_mma(bf16x8 b, bf16x8 a, f32x4 c) {
    if constexpr (I8) return __builtin_bit_cast(f32x4, __builtin_amdgcn_mfma_i32_16x16x64_i8(__builtin_bit_cast(i32x4, b), __builtin_bit_cast(i32x4, a), __builtin_bit_cast(i32x4, c), 0, 0, 0));
    else return __builtin_amdgcn_mfma_f32_16x16x32_bf16(b, a, c, 0, 0, 0);
}
__device__ __forceinline__ float rstd_from_parts(const float* ss, int row) {
    const f32x4* p = (const f32x4*)(ss + (size_t)row * 16);
    const f32x4 a = p[0], b = p[1], c = p[2], d = p[3];
    const float s = (((a[0] + a[1]) + (a[2] + a[3])) + ((b[0] + b[1]) + (b[2] + b[3]))) + (((c[0] + c[1]) + (c[2] + c[3])) + ((d[0] + d[1]) + (d[2] + d[3])));
    return rsqrtf(s * (1.0f / 1024.0f) + RMS_EPS);
}
typedef float f32x2 __attribute__((ext_vector_type(2)));
__device__ __forceinline__ float rstd_from_parts_q(const float* ss, int row, int fq) {
    const f32x4 a = *(const f32x4*)(ss + (size_t)row * 16 + 4 * fq);
    float s = (a[0] + a[1]) + (a[2] + a[3]);
    s += __shfl_xor(s, 16); s += __shfl_xor(s, 32);
    return rsqrtf(s * (1.0f / 1024.0f) + RMS_EPS);
}
__device__ __forceinline__ f32x2 silu_mul2(f32x2 g, f32x2 u, float c1, float rs2) {
    const f32x2 t = g * c1; f32x2 e; e.x = __builtin_amdgcn_exp2f(t.x); e.y = __builtin_amdgcn_exp2f(t.y);
    const f32x2 d = e + 1.0f; f32x2 r; r.x = __builtin_amdgcn_rcpf(d.x); r.y = __builtin_amdgcn_rcpf(d.y);
    return (g * u) * (r * rs2);
}

template <bool RS> struct EpiSwiGLU {
    static constexpr bool PERM = true, AFTER_DRAIN = false, I8 = false;
    bf16_t* O; int ldo; const float* ss;
    __device__ __forceinline__ void operator()(const f32x4 (&acc)[2][2][4][2], const Unit& u, int wr, int wc, int fr, int fq) const {
        const int row0 = u.pm * BM + wr * 64 + fr, col0 = u.pn * HALF + wc * 32 + 8 * fq;
        float rsv[2][4];
#pragma unroll
        for (int ai = 0; ai < 2; ++ai)
#pragma unroll
            for (int m = 0; m < 4; ++m) rsv[ai][m] = RS ? rstd_from_parts_q(ss, row0 + ai * HALF + m * 16, fq) : 1.0f;
#pragma unroll
        for (int ai = 0; ai < 2; ++ai)
#pragma unroll
            for (int m = 0; m < 4; ++m) {
                const int row = row0 + ai * HALF + m * 16;
                const float rs = rsv[ai][m], c1 = -1.4426950408889634f * rs, rs2 = rs * rs;
                const f32x4 g0 = acc[ai][0][m][0], g1 = acc[ai][0][m][1], u0 = acc[ai][1][m][0], u1 = acc[ai][1][m][1];
                const f32x2 a = silu_mul2((f32x2){g0[0], g0[1]}, (f32x2){u0[0], u0[1]}, c1, rs2), b = silu_mul2((f32x2){g0[2], g0[3]}, (f32x2){u0[2], u0[3]}, c1, rs2);
                const f32x2 c = silu_mul2((f32x2){g1[0], g1[1]}, (f32x2){u1[0], u1[1]}, c1, rs2), d = silu_mul2((f32x2){g1[2], g1[3]}, (f32x2){u1[2], u1[3]}, c1, rs2);
                u32x4 w; w.x = cvt_pk_bf16(a.x, a.y); w.y = cvt_pk_bf16(b.x, b.y); w.z = cvt_pk_bf16(c.x, c.y); w.w = cvt_pk_bf16(d.x, d.y);
                *(u32x4*)(O + (size_t)row * ldo + col0) = w;
            }
    }
};

template <bool BLKO> struct EpiSwiGLU8 {
    static constexpr bool PERM = true, AFTER_DRAIN = false, I8 = true;
    bf16_t* O; int ldo; const float* Rr; const float* sb;
    __device__ __forceinline__ void operator()(const f32x4 (&acc)[2][2][4][2], const Unit& u, int wr, int wc, int fr, int fq) const {
        const int row0 = u.pm * BM + wr * 64 + fr, col0 = u.pn * HALF + wc * 32 + 8 * fq;
        const float* sbp = sb + u.pn * BM + wc * 32 + 8 * fq;
        const f32x4 sg0 = *(const f32x4*)(sbp), sg1 = *(const f32x4*)(sbp + 4), su0 = *(const f32x4*)(sbp + HALF), su1 = *(const f32x4*)(sbp + HALF + 4);
        float rv[2][4];
#pragma unroll
        for (int ai = 0; ai < 2; ++ai)
#pragma unroll
            for (int m = 0; m < 4; ++m) rv[ai][m] = Rr[row0 + ai * HALF + m * 16];
#pragma unroll
        for (int ai = 0; ai < 2; ++ai)
#pragma unroll
            for (int m = 0; m < 4; ++m) {
                const int row = row0 + ai * HALF + m * 16;
                const float R = rv[ai][m], c1 = -1.4426950408889634f * R, r2 = R * R;
                const i32x4 gi0 = __builtin_bit_cast(i32x4, acc[ai][0][m][0]), gi1 = __builtin_bit_cast(i32x4, acc[ai][0][m][1]), ui0 = __builtin_bit_cast(i32x4, acc[ai][1][m][0]), ui1 = __builtin_bit_cast(i32x4, acc[ai][1][m][1]);
                const f32x4 g0 = __builtin_convertvector(gi0, f32x4) * sg0, g1 = __builtin_convertvector(gi1, f32x4) * sg1, u0 = __builtin_convertvector(ui0, f32x4) * su0, u1 = __builtin_convertvector(ui1, f32x4) * su1;
                const f32x2 a = silu_mul2((f32x2){g0[0], g0[1]}, (f32x2){u0[0], u0[1]}, c1, r2), b = silu_mul2((f32x2){g0[2], g0[3]}, (f32x2){u0[2], u0[3]}, c1, r2);
                const f32x2 c = silu_mul2((f32x2){g1[0], g1[1]}, (f32x2){u1[0], u1[1]}, c1, r2), d = silu_mul2((f32x2){g1[2], g1[3]}, (f32x2){u1[2], u1[3]}, c1, r2);
                u32x4 w; w.x = cvt_pk_bf16(a.x, a.y); w.y = cvt_pk_bf16(b.x, b.y); w.z = cvt_pk_bf16(c.x, c.y); w.w = cvt_pk_bf16(d.x, d.y);
                if constexpr (BLKO) __builtin_nontemporal_store(w, (u32x4*)(O + (((size_t)u.pm * (ldo / 64) + (col0 >> 6)) * 256 + (row & 255)) * 64 + (col0 & 63)));
                else *(u32x4*)(O + (size_t)row * ldo + col0) = w;
            }
    }
};

__device__ __forceinline__ f32x4 bf16lo4(unsigned a, unsigned b) { return (f32x4){__builtin_bit_cast(float, a << 16), __builtin_bit_cast(float, a & 0xffff0000u), __builtin_bit_cast(float, b << 16), __builtin_bit_cast(float, b & 0xffff0000u)}; }
template <bool AM> struct EpiResid {
    static constexpr bool PERM = true, AFTER_DRAIN = false, I8 = false;
    const bf16_t* R; bf16_t* Xb; float* ss; float alpha; float* am;
    __device__ __forceinline__ void operator()(const f32x4 (&acc)[2][2][4][2], const Unit& u, int wr, int wc, int fr, int fq) const {
        const int row0 = u.pm * BM + wr * 64 + fr, col0 = u.pn * BM + wc * 32 + 8 * fq;
        u32x4 pre[2][4][2];
#pragma unroll
        for (int ai = 0; ai < 2; ++ai)
#pragma unroll
            for (int m = 0; m < 4; ++m)
#pragma unroll
                for (int bj = 0; bj < 2; ++bj) pre[ai][m][bj] = *(const u32x4*)(R + (size_t)(row0 + ai * HALF + m * 16) * 1024 + col0 + bj * HALF);
#pragma unroll
        for (int ai = 0; ai < 2; ++ai)
#pragma unroll
            for (int m = 0; m < 4; ++m) {
                const int row = row0 + ai * HALF + m * 16; const size_t off = (size_t)row * 1024 + col0; float q = 0.f, mx = 0.f;
#pragma unroll
                for (int bj = 0; bj < 2; ++bj) {
                    const u32x4 p = pre[ai][m][bj];
                    const f32x4 v0 = bf16lo4(p.x, p.y) + acc[ai][bj][m][0] * alpha, v1 = bf16lo4(p.z, p.w) + acc[ai][bj][m][1] * alpha;
                    u32x4 w; w.x = cvt_pk_bf16(v0[0], v0[1]); w.y = cvt_pk_bf16(v0[2], v0[3]); w.z = cvt_pk_bf16(v1[0], v1[1]); w.w = cvt_pk_bf16(v1[2], v1[3]);
                    *(u32x4*)(Xb + off + bj * HALF) = w;
                    q += ((v0[0] * v0[0] + v0[1] * v0[1]) + (v0[2] * v0[2] + v0[3] * v0[3])) + ((v1[0] * v1[0] + v1[1] * v1[1]) + (v1[2] * v1[2] + v1[3] * v1[3]));
                    if (AM) { const f32x4 a0 = __builtin_elementwise_abs(v0), a1 = __builtin_elementwise_abs(v1); mx = fmaxf(mx, fmaxf(fmaxf(fmaxf(a0[0], a0[1]), fmaxf(a0[2], a0[3])), fmaxf(fmaxf(a1[0], a1[1]), fmaxf(a1[2], a1[3])))); }
                }
                q += __shfl_xor(q, 16); q += __shfl_xor(q, 32); if (fq == 0) ss[(size_t)row * 16 + u.pn * 4 + wc] = q;
                if (AM) { mx = fmaxf(mx, __shfl_xor(mx, 16)); mx = fmaxf(mx, __shfl_xor(mx, 32)); if (fq == 0) am[(size_t)row * 16 + u.pn * 4 + wc] = mx; }
            }
    }
};

constexpr float C2A = 0.17677669529663687f * 1.4426950408889634f;
constexpr float C2B = 0.125f * 1.4426950408889634f;
template <bool Q8> struct EpiProjT {
    static constexpr bool PERM = true, AFTER_DRAIN = false, I8 = Q8;
    bf16_t* O; const float* ss; const float* qn; const float* kn; const float* cs; const float* sb;
    __device__ __forceinline__ void operator()(const f32x4 (&acc)[2][2][4][2], const Unit& u, int wr, int wc, int fr, int fq) const {
        const int pn = u.pn, row0 = u.pm * BM + wr * 64 + fr, colbase = pn * 256 + wc * 64 + 8 * fq;
        int mode = 0; float qscale = 1.0f; const float* gain = qn;
        if (pn < 2) { mode = 1; qscale = C2A; } else if (pn < 6) { mode = 0; } else if (pn < 8) { mode = 2; qscale = C2B; } else if (wc < 2) { mode = 2; gain = kn; }
        f32x4 gv[2][2];
#pragma unroll
        for (int bj = 0; bj < 2; ++bj)
#pragma unroll
            for (int n = 0; n < 2; ++n) gv[bj][n] = (mode == 2) ? *(const f32x4*)(gain + 32 * bj + 8 * fq + 4 * n) : (f32x4){1.f, 1.f, 1.f, 1.f};
        f32x4 sbv[2][2];
#pragma unroll
        for (int bj = 0; bj < 2; ++bj)
#pragma unroll
            for (int n = 0; n < 2; ++n) sbv[bj][n] = Q8 ? *(const f32x4*)(sb + pn * 256 + bj * HALF + wc * 32 + 8 * fq + 4 * n) : (f32x4){1.f, 1.f, 1.f, 1.f};
#pragma unroll
        for (int ai = 0; ai < 2; ++ai)
#pragma unroll
            for (int m = 0; m < 4; ++m) {
                const int row = row0 + ai * HALF + m * 16;
                const float rs = Q8 ? ss[row] : rstd_from_parts_q(ss, row, fq);
                f32x4 v[2][2];
#pragma unroll
                for (int bj = 0; bj < 2; ++bj)
#pragma unroll
                    for (int n = 0; n < 2; ++n) { if constexpr (Q8) v[bj][n] = __builtin_convertvector(__builtin_bit_cast(i32x4, acc[ai][bj][m][n]), f32x4) * sbv[bj][n] * rs; else v[bj][n] = acc[ai][bj][m][n] * rs; }
                if (mode == 2) {
                    float q = 0.f;
#pragma unroll
                    for (int bj = 0; bj < 2; ++bj)
#pragma unroll
                        for (int n = 0; n < 2; ++n) q += (v[bj][n][0] * v[bj][n][0] + v[bj][n][1] * v[bj][n][1]) + (v[bj][n][2] * v[bj][n][2] + v[bj][n][3] * v[bj][n][3]);
                    q += __shfl_xor(q, 16); q += __shfl_xor(q, 32);
                    const float hr = rsqrtf(q * (1.0f / 64.0f) + RMS_EPS);
                    const int s = row & 4095;
#pragma unroll
                    for (int bj = 0; bj < 2; ++bj) {
                        const int pos = bj ? (s & 63) : (s >> 6);
                        const f32x4* t = (const f32x4*)(cs + (size_t)(pos * 16 + 4 * fq) * 2);
#pragma unroll
                        for (int n = 0; n < 2; ++n) {
                            const f32x4 x = v[bj][n] * hr * gv[bj][n], c = t[n];
                            f32x4 y; y[0] = x[0] * c[0] - x[1] * c[1]; y[1] = x[0] * c[1] + x[1] * c[0]; y[2] = x[2] * c[2] - x[3] * c[3]; y[3] = x[2] * c[3] + x[3] * c[2];
                            v[bj][n] = y * qscale;
                        }
                    }
                } else if (mode == 1) {
#pragma unroll
                    for (int bj = 0; bj < 2; ++bj)
#pragma unroll
                        for (int n = 0; n < 2; ++n) v[bj][n] = v[bj][n] * qscale;
                }
#pragma unroll
                for (int bj = 0; bj < 2; ++bj) {
                    u32x4 w; w.x = cvt_pk_bf16(v[bj][0][0], v[bj][0][1]); w.y = cvt_pk_bf16(v[bj][0][2], v[bj][0][3]); w.z = cvt_pk_bf16(v[bj][1][0], v[bj][1][1]); w.w = cvt_pk_bf16(v[bj][1][2], v[bj][1][3]);
                    __builtin_nontemporal_store(w, (u32x4*)(O + (size_t)(row >> 12) * QKV_BSTRIDE + (size_t)(row & 4095) * 2304 + colbase + 32 * bj));
                }
                asm volatile("" ::: "memory");
            }
    }
};
template <class Epi, class Sched, bool ALIGN_EPI = false, bool SP2 = false, bool BLK = false>
__device__ __forceinline__ void gemm_phase(PG8_LAS unsigned char* lds, const Gemm g, const Sched& S, const Epi& E) {
    const int tid = threadIdx.x, wid = __builtin_amdgcn_readfirstlane(tid >> 6), lane = tid & 63, wr = wid >> 2, wc = wid & 3, fr = lane & 15, fq = lane >> 4;
    const int K = g.K, nt = K / BK;
    unsigned voffA[2], voffB[2];
#pragma unroll
    for (int i = 0; i < 2; ++i) { int R, C; stage_rc(tid * 16 + i * 8192, R, C); const int Rb = Epi::PERM ? ((R & ~31) + perm32(R & 31)) : R;
        voffA[i] = BLK ? (unsigned)(R * 128 + C * 2) : (unsigned)(R * K + C) * 2u; voffB[i] = BLK ? (unsigned)(Rb * 128 + C * 2) : (unsigned)(Rb * K + C) * 2u; }
    const size_t kstep = BLK ? (size_t)32768 : (size_t)(BK * 2);
    const size_t hstep = BLK ? (size_t)16384 : (size_t)HALF * K * 2;
    const size_t tstep = BLK ? (size_t)(K / BK) * 32768 : 2 * hstep;
    const unsigned ldsw = (unsigned)wid * 1024u;
    const int aoff = lds_byte(wr * 64 + fr, fq * 8), boff = lds_byte(wc * 32 + fr, fq * 8);
#define PG8_SA(b, h) (((b) * 2 + (h)) * HTB)
#define PG8_SB(b, h) ((4 + (b) * 2 + (h)) * HTB)
#define PG8_STAGE(bufoff, gbase, voff) do { _Pragma("unroll") for (int _i = 0; _i < 2; ++_i) \
        __builtin_amdgcn_global_load_lds((const unsigned*)((const char*)(gbase) + (voff)[_i]), (PG8_LAS unsigned*)(lds + (bufoff) + ldsw + _i * 8192), 16, 0, 0); } while (0)
#define PG8_LDA(dst, b, h) do { _Pragma("unroll") for (int m = 0; m < 4; ++m) _Pragma("unroll") for (int k = 0; k < 2; ++k) dst[m][k] = *(const PG8_LAS bf16x8*)(lds + PG8_SA(b, h) + aoff + m * 2048 + k * 1024); } while (0)
#define PG8_LDB(dst, b, h) do { _Pragma("unroll") for (int n = 0; n < 2; ++n) _Pragma("unroll") for (int k = 0; k < 2; ++k) dst[n][k] = *(const PG8_LAS bf16x8*)(lds + PG8_SB(b, h) + boff + n * 2048 + k * 1024); } while (0)
#define PG8_MMA(ai, bj, At, Bt) do { __builtin_amdgcn_s_setprio(1); _Pragma("unroll") for (int m = 0; m < 4; ++m) _Pragma("unroll") for (int n = 0; n < 2; ++n) _Pragma("unroll") for (int k = 0; k < 2; ++k) \
        acc[ai][bj][m][n] = pg8_mma<Epi::I8>(Bt[n][k], At[m][k], acc[ai][bj][m][n]); __builtin_amdgcn_s_setprio(0); } while (0)
#define PG8_WAIT_V(n) asm volatile("s_waitcnt vmcnt(" #n ")" ::: "memory")
#define PG8_WAIT_L(n) asm volatile("s_waitcnt lgkmcnt(" #n ")" ::: "memory")
#define PG8_BAR __builtin_amdgcn_s_barrier()
#define PG8_SCHED __builtin_amdgcn_sched_barrier(0)
    Unit cur, nxt; int ui = 0;
    if (!S.next(0, cur)) return;
    f32x4 acc[2][2][4][2];
#pragma unroll
    for (int a = 0; a < 2; ++a)
#pragma unroll
        for (int b = 0; b < 2; ++b)
#pragma unroll
            for (int m = 0; m < 4; ++m)
#pragma unroll
                for (int n = 0; n < 2; ++n) acc[a][b][m][n] = (f32x4){0.f, 0.f, 0.f, 0.f};
    bf16x8 At[4][2], B0[2][2], B1[2][2];
    const char* cA = (const char*)g.A + (size_t)cur.pm * tstep; const char* cB = (const char*)g.Bt + (size_t)cur.pn * tstep;
    S.a_ready(cur);
    if constexpr (SP2) {
        PG8_STAGE(PG8_SB(0, 0), cB, voffB); PG8_STAGE(PG8_SB(0, 1), cB + hstep, voffB); PG8_STAGE(PG8_SA(0, 0), cA, voffA); PG8_STAGE(PG8_SA(0, 1), cA + hstep, voffA);
        if (wr == 1) PG8_BAR;
        PG8_WAIT_V(2); PG8_BAR;
        PG8_STAGE(PG8_SB(1, 0), cB + kstep, voffB); PG8_STAGE(PG8_SA(1, 0), cA + kstep, voffA); PG8_STAGE(PG8_SB(1, 1), cB + hstep + kstep, voffB);
        PG8_WAIT_V(6); PG8_BAR;
    } else {
        PG8_STAGE(PG8_SB(0, 0), cB, voffB); PG8_STAGE(PG8_SA(0, 0), cA, voffA); PG8_STAGE(PG8_SB(0, 1), cB + hstep, voffB); PG8_STAGE(PG8_SA(0, 1), cA + hstep, voffA);
        if (wr == 1) PG8_BAR;
        PG8_WAIT_V(4); PG8_BAR;
        PG8_STAGE(PG8_SB(1, 0), cB + kstep, voffB); PG8_STAGE(PG8_SA(1, 0), cA + kstep, voffA); PG8_STAGE(PG8_SB(1, 1), cB + hstep + kstep, voffB);
        PG8_WAIT_V(6); PG8_BAR;
    }
    for (;;) {
        const bool has_next = S.next(ui + 1, nxt);
        const char* nA = has_next ? (const char*)g.A + (size_t)nxt.pm * tstep : cA; const char* nB = has_next ? (const char*)g.Bt + (size_t)nxt.pn * tstep : cB;
        for (int t = 0; t < nt; t += 2) {
            const bool last = (t == nt - 2);
            const char* a1 = cA + (size_t)(t + 1) * kstep;
            const char* a2 = last ? nA : cA + (size_t)(t + 2) * kstep; const char* b2 = last ? nB : cB + (size_t)(t + 2) * kstep;
            const char* a3 = a2 + kstep; const char* b3 = b2 + kstep;
            if (last && has_next) S.a_ready(nxt);
            if constexpr (SP2) {
            PG8_LDB(B0, 0, 0); PG8_LDB(B1, 0, 1); PG8_SCHED; PG8_LDA(At, 0, 0); PG8_STAGE(PG8_SA(1, 1), a1 + hstep, voffA);
            PG8_WAIT_V(8); PG8_WAIT_L(0); PG8_BAR; PG8_MMA(0, 0, At, B0); PG8_MMA(0, 1, At, B1); PG8_BAR; PG8_SCHED;
            PG8_LDA(At, 0, 1); PG8_STAGE(PG8_SB(0, 0), b2, voffB); PG8_STAGE(PG8_SB(0, 1), b2 + hstep, voffB); PG8_STAGE(PG8_SA(0, 0), a2, voffA);
            PG8_WAIT_V(8); PG8_WAIT_L(0); PG8_BAR; PG8_MMA(1, 0, At, B0); PG8_MMA(1, 1, At, B1); PG8_BAR; PG8_SCHED;
            PG8_LDB(B0, 1, 0); PG8_LDB(B1, 1, 1); PG8_SCHED; PG8_LDA(At, 1, 0); PG8_STAGE(PG8_SA(0, 1), a2 + hstep, voffA);
            PG8_WAIT_V(8); PG8_WAIT_L(0); PG8_BAR; PG8_MMA(0, 0, At, B0); PG8_MMA(0, 1, At, B1); PG8_BAR; PG8_SCHED;
            PG8_LDA(At, 1, 1); PG8_STAGE(PG8_SB(1, 0), b3, voffB); PG8_STAGE(PG8_SB(1, 1), b3 + hstep, voffB); PG8_STAGE(PG8_SA(1, 0), a3, voffA);
            PG8_WAIT_V(8); PG8_WAIT_L(0); PG8_BAR; PG8_MMA(1, 0, At, B0); PG8_MMA(1, 1, At, B1); PG8_BAR; PG8_SCHED;
            } else {
            PG8_LDB(B0, 0, 0); PG8_SCHED; PG8_LDA(At, 0, 0); PG8_STAGE(PG8_SA(1, 1), a1 + hstep, voffA);
            PG8_WAIT_L(8); PG8_BAR; PG8_WAIT_L(0); PG8_MMA(0, 0, At, B0); PG8_BAR; PG8_SCHED;
            PG8_LDB(B1, 0, 1); PG8_STAGE(PG8_SB(0, 0), b2, voffB);
            PG8_BAR; PG8_WAIT_L(0); PG8_MMA(0, 1, At, B1); PG8_BAR;
            PG8_LDA(At, 0, 1); PG8_STAGE(PG8_SA(0, 0), a2, voffA);
            PG8_BAR; PG8_WAIT_L(0); PG8_MMA(1, 0, At, B0); PG8_BAR; PG8_SCHED;
            PG8_STAGE(PG8_SB(0, 1), b2 + hstep, voffB);
            PG8_WAIT_V(6); PG8_BAR; PG8_MMA(1, 1, At, B1); PG8_BAR;
            PG8_LDB(B0, 1, 0); PG8_SCHED; PG8_LDA(At, 1, 0); PG8_STAGE(PG8_SA(0, 1), a2 + hstep, voffA);
            PG8_WAIT_L(8); PG8_BAR; PG8_WAIT_L(0); PG8_MMA(0, 0, At, B0); PG8_BAR; PG8_SCHED;
            PG8_LDB(B1, 1, 1); PG8_STAGE(PG8_SB(1, 0), b3, voffB);
            PG8_BAR; PG8_WAIT_L(0); PG8_MMA(0, 1, At, B1); PG8_BAR;
            PG8_LDA(At, 1, 1); PG8_STAGE(PG8_SA(1, 0), a3, voffA);
            PG8_BAR; PG8_WAIT_L(0); PG8_MMA(1, 0, At, B0); PG8_BAR; PG8_SCHED;
            PG8_STAGE(PG8_SB(1, 1), b3 + hstep, voffB);
            PG8_WAIT_V(6); PG8_BAR; PG8_MMA(1, 1, At, B1); PG8_BAR;
            }
        }
        if constexpr (ALIGN_EPI) { if (wr == 0) PG8_BAR; }
        if constexpr (!Epi::AFTER_DRAIN) { E(acc, cur, wr, wc, fr, fq); S.done(cur); }
        if (!has_next) break;
#pragma unroll
        for (int a = 0; a < 2; ++a)
#pragma unroll
            for (int b = 0; b < 2; ++b)
#pragma unroll
                for (int m = 0; m < 4; ++m)
#pragma unroll
                    for (int n = 0; n < 2; ++n) acc[a][b][m][n] = (f32x4){0.f, 0.f, 0.f, 0.f};
        cur = nxt; cA = nA; cB = nB; ++ui;
        if constexpr (ALIGN_EPI) { if (wr == 1) PG8_BAR; }
    }
    PG8_WAIT_V(0);
    if constexpr (!ALIGN_EPI) { if (wr == 0) PG8_BAR; }
    PG8_BAR;
    if constexpr (Epi::AFTER_DRAIN) { E.fused(acc, cur, wr, wc, fr, fq, lds, wid, lane); S.done(cur); }
#undef PG8_SA
#undef PG8_SB
#undef PG8_STAGE
#undef PG8_LDA
#undef PG8_LDB
#undef PG8_MMA
#undef PG8_WAIT_V
#undef PG8_WAIT_L
#undef PG8_BAR
#undef PG8_SCHED
}
}
namespace att {
using bf16 = unsigned short;
using bf16x8 = __attribute__((ext_vector_type(8))) short;
using s16x4 = __attribute__((ext_vector_type(4))) short;
using f32x16 = __attribute__((ext_vector_type(16))) float;
using u32x4 = __attribute__((ext_vector_type(4))) unsigned;
using f32x4 = __attribute__((ext_vector_type(4))) float;
constexpr int SEQ = 4096, PITCH = 2304, KVBLK = 64, NT = SEQ / KVBLK, NW = 8;
constexpr int NSLOT = 3, SLOTB = 8192;
constexpr int LDS_K = 0, LDS_V = NSLOT * SLOTB, LDS_WS = 2 * NSLOT * SLOTB, LDS_TBL = LDS_WS + NW * 256, LDS_OST = LDS_TBL + 2048, LDS_BYTES = LDS_OST + NW * 8192;
constexpr int TBL_N = 384, TBL_OFF = 192;
__device__ __forceinline__ int crow(int r, int hi) { return (r & 3) + 8 * (r >> 2) + 4 * hi; }
#define ATT_SBAR() __builtin_amdgcn_sched_barrier(0)
__device__ __forceinline__ void glds16(const void* gsrc, unsigned lds_dst) { unsigned keep;
  asm volatile("s_mov_b32 %0, m0\n\ts_mov_b32 m0, %2\n\ts_nop 0\n\tglobal_load_lds_dwordx4 %1, off\n\ts_mov_b32 m0, %0" : "=&s"(keep) : "v"(gsrc), "s"(lds_dst) : "memory"); }
typedef float f32x2_t __attribute__((ext_vector_type(2))); typedef __bf16 bf16x2_t __attribute__((ext_vector_type(2)));
__device__ __forceinline__ unsigned cvtpk_s(float lo, float hi) { f32x2_t v = {lo, hi}; bf16x2_t b = __builtin_convertvector(v, bf16x2_t); return __builtin_bit_cast(unsigned, b); }
__device__ __forceinline__ void pv(f32x16* o, int vb, bf16x8 pa0, bf16x8 pa1, bf16x8 pa2, bf16x8 pa3) {
  #pragma unroll
  for (int d0 = 0; d0 < 2; ++d0) { s16x4 lo[4], hi[4];
    #pragma unroll
    for (int ks = 0; ks < 4; ++ks) {
      asm volatile("ds_read_b64_tr_b16 %0,%1 offset:%c2" : "=&v"(lo[ks]) : "v"(vb), "i"(d0 * 4096 + ks * 1024) : "memory");
      asm volatile("ds_read_b64_tr_b16 %0,%1 offset:%c2" : "=&v"(hi[ks]) : "v"(vb), "i"(d0 * 4096 + ks * 1024 + 512) : "memory"); }
    asm volatile("s_waitcnt lgkmcnt(0)" ::: "memory"); ATT_SBAR();
    #define ATT_PK(k) (bf16x8){lo[k][0], lo[k][1], lo[k][2], lo[k][3], hi[k][0], hi[k][1], hi[k][2], hi[k][3]}
    o[d0] = __builtin_amdgcn_mfma_f32_32x32x16_bf16(pa0, ATT_PK(0), o[d0], 0, 0, 0);
    o[d0] = __builtin_amdgcn_mfma_f32_32x32x16_bf16(pa1, ATT_PK(1), o[d0], 0, 0, 0);
    o[d0] = __builtin_amdgcn_mfma_f32_32x32x16_bf16(pa2, ATT_PK(2), o[d0], 0, 0, 0);
    o[d0] = __builtin_amdgcn_mfma_f32_32x32x16_bf16(pa3, ATT_PK(3), o[d0], 0, 0, 0);
    #undef ATT_PK
  }
}
typedef __attribute__((address_space(3))) const char* lds_cptr;
typedef __attribute__((address_space(3))) float* lds_fptr;

template <bool MODEA>
__device__ __forceinline__ void attn_unit_simple(int b, int h, int qb, const bf16* QKV, bf16* AO, char* shm, const float* bias_tab, float lam, const float* subln) {
  const int tid = threadIdx.x, lane = tid & 63, r32 = lane & 31, hi = lane >> 5; const int wid = __builtin_amdgcn_readfirstlane(tid >> 6);
  const int part = MODEA ? (wid >> 2) : 0, w4 = MODEA ? (wid & 3) : wid;
  const int q0 = MODEA ? qb * 128 : qb * 256, qw0 = q0 + 32 * w4;
  const long rowbase = (long)b * SEQ;
  const int qcol = MODEA ? h * 64 + 32 * part : 1536 + h * 64;
  const int kcol = MODEA ? 512 + h * 64 : 2048 + (h >> 2) * 64;
  const int vcol = MODEA ? 1024 + h * 64 : 2176 + (h >> 2) * 64;
  constexpr int NDK = MODEA ? 2 : 4;
  const bf16* QKVb = QKV + (long)b * QKV_BSTRIDE;
  const bf16* Qw = QKVb + (long)qw0 * PITCH + qcol;
  const bf16* Kh = QKVb + kcol; const bf16* Vh = QKVb + vcol;
  const unsigned lds0 = (unsigned)(uintptr_t)shm;
  const lds_cptr shm3 = (lds_cptr)shm;
  lds_fptr wsf = (lds_fptr)(shm3 + LDS_WS) + wid * 64;
  lds_fptr tbl = (lds_fptr)(shm3 + LDS_TBL);
  const bf16* ksrc = Kh + (long)lane * PITCH + wid * 8;
  const bf16* vsrc = Vh + (long)(16 * (wid & 3) + (lane >> 2)) * PITCH + (wid >> 2) * 32 + (lane & 3) * 8;
  const unsigned kdst = lds0 + LDS_K + wid * 1024, vdst = lds0 + LDS_V + wid * 1024;
  const int vb0 = (int)(lds0 + LDS_V) + ((lane >> 4) & 1) * 32 + (lane & 3) * 8 + (4 * hi + ((lane & 15) >> 2)) * 64;
  const lds_cptr kp0 = shm3 + LDS_K + part * 4096 + hi * 1024 + r32 * 16;
  if (MODEA) { if (tid < TBL_N) tbl[tid] = bias_tab[h * TBL_N + tid]; }
  bf16x8 qr[NDK];
  #pragma unroll
  for (int d0 = 0; d0 < NDK; ++d0) qr[d0] = *reinterpret_cast<const bf16x8*>(&Qw[(long)r32 * PITCH + d0 * 16 + hi * 8]);
  float m_run = -1e30f, l_reg = 0.f; f32x16 o[2]; o[0] = f32x16{}; o[1] = f32x16{};
  float cL = 0.f, cR = 0.f;
  for (int t = 0; t < NT; ++t) {
    asm volatile("s_waitcnt lgkmcnt(0)\n\ts_barrier" ::: "memory");
    glds16(ksrc + (long)t * KVBLK * PITCH, (unsigned)__builtin_amdgcn_readfirstlane(kdst));
    glds16(vsrc + (long)t * KVBLK * PITCH, (unsigned)__builtin_amdgcn_readfirstlane(vdst));
    asm volatile("s_waitcnt vmcnt(0)\n\ts_barrier" ::: "memory");
    if (MODEA && t == 0) { cL = tbl[0]; cR = tbl[TBL_N - 1]; }
    f32x16 p0, p1;
    #pragma unroll
    for (int d0 = 0; d0 < NDK; ++d0) {
      const bf16x8 b0 = *(const __attribute__((address_space(3))) bf16x8*)(kp0 + d0 * 2048);
      const bf16x8 b1 = *(const __attribute__((address_space(3))) bf16x8*)(kp0 + d0 * 2048 + 512);
      if (d0 == 0) { p0 = __builtin_amdgcn_mfma_f32_32x32x16_bf16(b0, qr[0], f32x16{}, 0, 0, 0); p1 = __builtin_amdgcn_mfma_f32_32x32x16_bf16(b1, qr[0], f32x16{}, 0, 0, 0); }
      else { p0 = __builtin_amdgcn_mfma_f32_32x32x16_bf16(b0, qr[d0], p0, 0, 0, 0); p1 = __builtin_amdgcn_mfma_f32_32x32x16_bf16(b1, qr[d0], p1, 0, 0, 0); }
    }
    if (MODEA) {
      const int kt = t * KVBLK;
      if (kt + 63 - qw0 <= -91) {
        #pragma unroll
        for (int r = 0; r < 16; ++r) { p0[r] += cL; p1[r] += cL; }
      } else if (kt - (qw0 + 31) >= 91) {
        #pragma unroll
        for (int r = 0; r < 16; ++r) { p0[r] += cR; p1[r] += cR; }
      } else {
        const lds_fptr tb = tbl + (kt - (qw0 + r32) + TBL_OFF + 4 * hi);
        #pragma unroll
        for (int r = 0; r < 16; ++r) { p0[r] += tb[(r & 3) + 8 * (r >> 2)]; p1[r] += tb[32 + (r & 3) + 8 * (r >> 2)]; }
      }
    }
    float rm = fmaxf(p0[0], p1[0]);
    #pragma unroll
    for (int r = 1; r < 16; ++r) rm = fmaxf(rm, fmaxf(p0[r], p1[r]));
    { auto rr = __builtin_amdgcn_permlane32_swap(__float_as_uint(rm), __float_as_uint(rm), false, false); rm = fmaxf(__uint_as_float(rr[0]), __uint_as_float(rr[1])); }
    const float mnew = fmaxf(m_run, rm);
    if (__any(mnew > m_run)) {
      const float alpha = __builtin_amdgcn_exp2f(m_run - mnew);
      l_reg *= alpha; m_run = mnew;
      if (hi == 0) wsf[r32] = alpha;
      asm volatile("s_waitcnt lgkmcnt(0)" ::: "memory");
      #pragma unroll
      for (int d = 0; d < 2; ++d)
        #pragma unroll
        for (int r = 0; r < 16; ++r) o[d][r] *= wsf[crow(r, hi)];
    }
    float sacc = 0.f;
    #pragma unroll
    for (int r = 0; r < 16; ++r) { p0[r] = __builtin_amdgcn_exp2f(p0[r] - m_run); p1[r] = __builtin_amdgcn_exp2f(p1[r] - m_run); sacc += p0[r] + p1[r]; }
    l_reg += sacc;
    u32x4 pw0, pw1, pw2, pw3;
    pw0 = (u32x4){cvtpk_s(p0[0], p0[1]), cvtpk_s(p0[2], p0[3]), cvtpk_s(p0[4], p0[5]), cvtpk_s(p0[6], p0[7])};
    pw1 = (u32x4){cvtpk_s(p0[8], p0[9]), cvtpk_s(p0[10], p0[11]), cvtpk_s(p0[12], p0[13]), cvtpk_s(p0[14], p0[15])};
    pw2 = (u32x4){cvtpk_s(p1[0], p1[1]), cvtpk_s(p1[2], p1[3]), cvtpk_s(p1[4], p1[5]), cvtpk_s(p1[6], p1[7])};
    pw3 = (u32x4){cvtpk_s(p1[8], p1[9]), cvtpk_s(p1[10], p1[11]), cvtpk_s(p1[12], p1[13]), cvtpk_s(p1[14], p1[15])};
    ATT_SBAR();
    pv(o, vb0, __builtin_bit_cast(bf16x8, pw0), __builtin_bit_cast(bf16x8, pw1), __builtin_bit_cast(bf16x8, pw2), __builtin_bit_cast(bf16x8, pw3));
  }
  { auto rr = __builtin_amdgcn_permlane32_swap(__float_as_uint(l_reg), __float_as_uint(l_reg), false, false); l_reg = __uint_as_float(rr[0]) + __uint_as_float(rr[1]); }
  if (hi == 0) wsf[32 + r32] = l_reg;
  asm volatile("s_waitcnt lgkmcnt(0)" ::: "memory");
  float rli[16];
  #pragma unroll
  for (int r = 0; r < 16; ++r) rli[r] = __builtin_amdgcn_rcpf(wsf[32 + crow(r, hi)]);
  if (!MODEA) {
    bf16* Ow = AO + (rowbase + qw0) * 1024 + 512 + h * 64;
    __attribute__((address_space(3))) bf16* stg = (__attribute__((address_space(3))) bf16*)(shm3 + LDS_OST) + wid * 4096;
    #pragma unroll
    for (int r = 0; r < 16; ++r) { const int orow = crow(r, hi);
      #pragma unroll
      for (int d0 = 0; d0 < 2; ++d0) stg[orow * 64 + d0 * 32 + r32] = (bf16)(cvtpk_s(o[d0][r] * rli[r], 0.f) & 0xffffu); }
    asm volatile("s_waitcnt lgkmcnt(0)" ::: "memory");
    #pragma unroll
    for (int i = 0; i < 4; ++i) { const int row = i * 8 + (lane >> 3), ch = lane & 7; const u32x4 v = *(const __attribute__((address_space(3))) u32x4*)(stg + row * 64 + ch * 8); *(u32x4*)(Ow + (long)row * 1024 + ch * 8) = v; }
  } else {
    lds_fptr stg = (lds_fptr)(shm3 + LDS_OST) + wid * 2048;
    #pragma unroll
    for (int r = 0; r < 16; ++r) { const int orow = crow(r, hi);
      #pragma unroll
      for (int d0 = 0; d0 < 2; ++d0) stg[orow * 64 + d0 * 32 + r32] = o[d0][r] * rli[r]; }
    asm volatile("s_waitcnt lgkmcnt(0)\n\ts_barrier" ::: "memory");
    const lds_fptr s1 = (lds_fptr)(shm3 + LDS_OST) + w4 * 2048, s2 = s1 + 4 * 2048;
    bf16* Ow = AO + (rowbase + q0 + 32 * w4) * 1024 + h * 64;
    #pragma unroll
    for (int i = 0; i < 2; ++i) {
      const int row = 16 * part + i * 8 + (lane >> 3), ch = lane & 7;
      const f32x4 a0 = *(const __attribute__((address_space(3))) f32x4*)(s1 + row * 64 + ch * 8), a1 = *(const __attribute__((address_space(3))) f32x4*)(s1 + row * 64 + ch * 8 + 4);
      const f32x4 b0 = *(const __attribute__((address_space(3))) f32x4*)(s2 + row * 64 + ch * 8), b1 = *(const __attribute__((address_space(3))) f32x4*)(s2 + row * 64 + ch * 8 + 4);
      const f32x4 d0v = a0 - b0 * lam, d1v = a1 - b1 * lam;
      float q = ((d0v[0] * d0v[0] + d0v[1] * d0v[1]) + (d0v[2] * d0v[2] + d0v[3] * d0v[3])) + ((d1v[0] * d1v[0] + d1v[1] * d1v[1]) + (d1v[2] * d1v[2] + d1v[3] * d1v[3]));
      q += __shfl_xor(q, 1); q += __shfl_xor(q, 2); q += __shfl_xor(q, 4);
      const float rs = rsqrtf(q * (1.0f / 64.0f) + 1e-6f) * 0.8f;
      const f32x4 g0 = *(const f32x4*)(subln + ch * 8), g1 = *(const f32x4*)(subln + ch * 8 + 4);
      const f32x4 y0 = d0v * rs * g0, y1 = d1v * rs * g1;
      u32x4 w; w.x = cvtpk_s(y0[0], y0[1]); w.y = cvtpk_s(y0[2], y0[3]); w.z = cvtpk_s(y1[0], y1[1]); w.w = cvtpk_s(y1[2], y1[3]);
      *(u32x4*)(Ow + (long)row * 1024 + ch * 8) = w;
    }
  }
  asm volatile("s_waitcnt lgkmcnt(0)\n\ts_barrier" ::: "memory");
}

__device__ __forceinline__ float max3f(float a, float b, float c) { float r; asm("v_max3_f32 %0, %1, %2, %3" : "=v"(r) : "v"(a), "v"(b), "v"(c)); return r; }
__device__ __forceinline__ float max2f(float a, float b) { float r; asm("v_max_f32_e32 %0, %1, %2" : "=v"(r) : "v"(a), "v"(b)); return r; }
__device__ __forceinline__ float fadd_s(float a, float b) { float r; asm("v_add_f32_e32 %0, %1, %2" : "=v"(r) : "v"(a), "v"(b)); return r; }
__device__ __forceinline__ float fsub_s(float a, float b) { float r; asm("v_sub_f32_e32 %0, %1, %2" : "=v"(r) : "v"(a), "v"(b)); return r; }
#define ATT_WAIT_BAR(N) asm volatile("s_waitcnt vmcnt(" #N ") lgkmcnt(0)\n\ts_barrier" ::: "memory")
typedef short v4i16_t __attribute__((ext_vector_type(4)));
__device__ __forceinline__ void kload2(bf16x8* kf, lds_cptr kp, int j) { kf[2 * j] = *(const __attribute__((address_space(3))) bf16x8*)(kp + j * 2048); kf[2 * j + 1] = *(const __attribute__((address_space(3))) bf16x8*)(kp + j * 2048 + 512); }
__device__ __forceinline__ s16x4 vtr(lds_cptr p) { return __builtin_bit_cast(s16x4, __builtin_amdgcn_ds_read_tr16_b64_v4i16((__attribute__((address_space(3))) v4i16_t*)p)); }
__device__ __forceinline__ float rowmax(const f32x16& p0, const f32x16& p1) {
  float a = max3f(p0[0], p0[1], p1[0]), b = max3f(p0[2], p0[3], p1[1]); a = max3f(a, p1[2], p1[3]);
  #pragma unroll
  for (int r = 4; r < 16; r += 4) { a = max3f(a, p0[r], p0[r + 1]); b = max3f(b, p0[r + 2], p0[r + 3]); a = max3f(a, p1[r], p1[r + 1]); b = max3f(b, p1[r + 2], p1[r + 3]); }
  const float m = max2f(a, b);
  auto rr = __builtin_amdgcn_permlane32_swap(__float_as_uint(m), __float_as_uint(m), false, false);
  return max2f(__uint_as_float(rr[0]), __uint_as_float(rr[1]));
}
#define ATT_MFMA(a, b, c) __builtin_amdgcn_mfma_f32_32x32x16_bf16(a, b, c, 0, 0, 0)

#ifndef ATT_STAGGER
#define ATT_STAGGER 0
#endif
#ifndef ATT_RSM16
#define ATT_RSM16(modea) true
#endif
#ifndef ATT_RSM
#define ATT_RSM(modea) false
#endif
template <bool MODEA>
__device__ __forceinline__ bool attn_unit(int b, int h, int qb, const bf16* QKV, bf16* AO, char* shm, const float* bias_tab, float lam, const float* subln, bool pre, bool nxt, int nxoff = 0) {
  const int tid = threadIdx.x, lane = tid & 63, r32 = lane & 31, hi = lane >> 5; const int wid = __builtin_amdgcn_readfirstlane(tid >> 6);
  const int part = MODEA ? (wid >> 2) : 0, w4 = MODEA ? (wid & 3) : wid;
  const int q0 = MODEA ? qb * 128 : qb * 256, qw0 = q0 + 32 * w4;
  const long rowbase = (long)b * SEQ;
  const int qcol = MODEA ? h * 64 + 32 * part : 1536 + h * 64;
  const int kcol = MODEA ? 512 + h * 64 : 2048 + (h >> 2) * 64;
  const int vcol = MODEA ? 1024 + h * 64 : 2176 + (h >> 2) * 64;
  constexpr int NDK = MODEA ? 2 : 4;
  constexpr bool RSM = ATT_RSM(MODEA); constexpr bool RSM16 = ATT_RSM16(MODEA);
  const bf16* QKVb = QKV + (long)b * QKV_BSTRIDE;
  const bf16* Qw = QKVb + (long)qw0 * PITCH + qcol;
  const bf16* Kh = QKVb + kcol; const bf16* Vh = QKVb + vcol;
  const unsigned lds0 = (unsigned)(uintptr_t)shm;
  const lds_cptr shm3 = (lds_cptr)shm;
  lds_fptr wsf = (lds_fptr)(shm3 + LDS_WS) + wid * 64;
  __attribute__((address_space(3))) unsigned* flag = (__attribute__((address_space(3))) unsigned*)(shm3 + LDS_WS);
  lds_fptr tbl = (lds_fptr)(shm3 + LDS_TBL);
  const bf16* ksrc = Kh + (long)lane * PITCH + wid * 8;
  const bf16* vsrc = Vh + (long)(16 * (wid & 3) + (lane >> 2)) * PITCH + (wid >> 2) * 32 + (lane & 3) * 8;
  const unsigned kdst = lds0 + LDS_K + wid * 1024, vdst = lds0 + LDS_V + wid * 1024;
  #define DMA_K(t, slot) glds16(ksrc + (long)(t) * KVBLK * PITCH, (unsigned)__builtin_amdgcn_readfirstlane(kdst + (slot)))
  #define DMA_V(t, slot) glds16(vsrc + (long)(t) * KVBLK * PITCH, (unsigned)__builtin_amdgcn_readfirstlane(vdst + (slot)))
  const int vb0 = (int)(lds0 + LDS_V) + ((lane >> 4) & 1) * 32 + (lane & 3) * 8 + (4 * hi + ((lane & 15) >> 2)) * 64;
  bf16x8 kf[2 * NDK];
  const lds_cptr kp0 = shm3 + LDS_K + part * 4096 + hi * 1024 + r32 * 16;
  const lds_cptr vp0 = shm3 + LDS_V + ((lane >> 4) & 1) * 32 + (lane & 3) * 8 + (4 * hi + ((lane & 15) >> 2)) * 64;
  int tL = 0, tR = NT; float cL = 0.f, cR = 0.f;
  if (tid == 0) flag[0] = 0u;
  if (MODEA) { if (tid < TBL_N) tbl[tid] = bias_tab[h * TBL_N + tid]; cL = bias_tab[h * TBL_N]; cR = bias_tab[h * TBL_N + TBL_N - 1];
    tL = (qw0 >= 154) ? (qw0 - 154) / 64 + 1 : 0; tR = (qw0 + 122 + 63) / 64; }
  if (!pre) { DMA_K(0, 0); DMA_V(0, 0); DMA_K(1, SLOTB); }
  bf16x8 qr[NDK];
  #pragma unroll
  for (int d0 = 0; d0 < NDK; ++d0) qr[d0] = *reinterpret_cast<const bf16x8*>(&Qw[(long)r32 * PITCH + d0 * 16 + hi * 8]);
  f32x16 o[2]; o[0] = f32x16{}; o[1] = f32x16{}; f32x16 ol = f32x16{};
  f32x16 negm = f32x16{};
  if (MODEA) { const float c0_ = (0 < tL) ? cL : 0.f;
    #pragma unroll
    for (int r = 0; r < 16; ++r) negm[r] = c0_; }
  asm volatile("" : "+v"(negm));
  f32x4 ol4 = {0.f, 0.f, 0.f, 0.f}; bf16x8 bsel; { const short o1 = (((lane & 15) < 2) && ((lane & 15) == ((lane >> 4) & 1))) ? (short)0x3F80 : (short)0;
    #pragma unroll
    for (int j = 0; j < 8; ++j) bsel[j] = o1; }
  asm volatile("" : "+v"(bsel));
  bf16x8 ones; { const short o1 = (short)0x3F80;
    #pragma unroll
    for (int j = 0; j < 8; ++j) ones[j] = o1; }
  asm volatile("" : "+v"(ones));
  #define CINIT (MODEA ? negm : f32x16{})
  #define BIAS(C0, C1, t) do { if (MODEA) { if ((t) >= tL && (t) < tR) { const lds_fptr tb_ = tbl + ((t) * KVBLK - (qw0 + r32) + TBL_OFF + 4 * hi); \
      _Pragma("unroll") for (int r = 0; r < 16; ++r) { C0[r] += tb_[(r & 3) + 8 * (r >> 2)]; C1[r] += tb_[32 + (r & 3) + 8 * (r >> 2)]; } } } } while (0)
  #define REGION(t) do { if (MODEA) { if ((t) == tL || (t) == tR) { const float cn_ = ((t) < tL) ? cL : (((t) >= tR) ? cR : 0.f); \
      _Pragma("unroll") for (int r = 0; r < 16; ++r) negm[r] = cn_; asm volatile("" : "+v"(negm)); } } } while (0)
  f32x16 pA0, pA1, pB0, pB1;
  int sl_prev = 0, sl_cur = 0, sl_next = SLOTB;
  #define ROT() do { sl_prev = sl_cur; sl_cur = sl_next; sl_next = (sl_next == (NSLOT - 1) * SLOTB) ? 0 : sl_next + SLOTB; } while (0)
  if (!pre) { DMA_K(2, 2 * SLOTB); ATT_WAIT_BAR(3); }
  else { if (MODEA) { ATT_WAIT_BAR(2); } else { ATT_WAIT_BAR(4); } }
  { const lds_cptr kb = kp0;
    #pragma unroll
    for (int d0 = 0; d0 < NDK; ++d0) {
      const bf16x8 b0 = *(const __attribute__((address_space(3))) bf16x8*)(kb + d0 * 2048);
      const bf16x8 b1 = *(const __attribute__((address_space(3))) bf16x8*)(kb + d0 * 2048 + 512);
      if (d0 == 0) { pA0 = ATT_MFMA(b0, qr[0], CINIT); pA1 = ATT_MFMA(b1, qr[0], CINIT); }
      else { pA0 = ATT_MFMA(b0, qr[d0], pA0); pA1 = ATT_MFMA(b1, qr[d0], pA1); } } }
  BIAS(pA0, pA1, 0);
  _Pragma("unroll") for (int r = 0; r < 16; ++r) { pA0[r] = __builtin_amdgcn_exp2f(pA0[r]); pA1[r] = __builtin_amdgcn_exp2f(pA1[r]); }
  ATT_WAIT_BAR(0);
  if (ATT_STAGGER) { DMA_V(1, SLOTB); DMA_K(3, 0); } else { DMA_K(3, 0); DMA_V(1, SLOTB); }
  ROT();
  #pragma unroll
  for (int j = 0; j < NDK; ++j) kload2(kf, kp0 + sl_cur, j);
  ATT_WAIT_BAR(2);
  if (ATT_STAGGER) { if (wid >= 4) asm volatile("s_barrier" ::: "memory"); }
  s16x4 vlo[8], vhi[8]; u32x4 pw0, pw1, pw2, pw3;
  #define PKW(P, B) cvtpk_s(P[B], P[B + 1])
  #define PAF(k) __builtin_bit_cast(bf16x8, pw##k)
  #define VFR(i) (bf16x8){vlo[i][0], vlo[i][1], vlo[i][2], vlo[i][3], vhi[i][0], vhi[i][1], vhi[i][2], vhi[i][3]}
  #define PIN(x) asm volatile("" : "+v"(x))
  #define QKG(g, C0, C1) do { if constexpr (NDK == 4) { if constexpr (((g) & 1) != 0) { if constexpr ((g) < 2) C1 = ATT_MFMA(kf[g], qr[(g) >> 1], CINIT); else C1 = ATT_MFMA(kf[g], qr[(g) >> 1], C1); } \
                                                        else { if constexpr ((g) < 2) C0 = ATT_MFMA(kf[g], qr[(g) >> 1], CINIT); else C0 = ATT_MFMA(kf[g], qr[(g) >> 1], C0); } } \
      else if constexpr ((g) < 4) { constexpr int i_ = (g); if constexpr ((i_ & 1) != 0) { if constexpr (i_ < 2) C1 = ATT_MFMA(kf[i_], qr[i_ >> 1], CINIT); else C1 = ATT_MFMA(kf[i_], qr[i_ >> 1], C1); } \
                                                        else { if constexpr (i_ < 2) C0 = ATT_MFMA(kf[i_], qr[i_ >> 1], CINIT); else C0 = ATT_MFMA(kf[i_], qr[i_ >> 1], C0); } } } while (0)
  #define ROWSUM(k) do { if constexpr (RSM) ol = ATT_MFMA(PAF(k), ones, ol); if constexpr (RSM16) ol4 = __builtin_amdgcn_mfma_f32_16x16x32_bf16(PAF(k), bsel, ol4, 0, 0, 0); } while (0)
  float l_reg = 0.f;
  #define GAPA(g, C0, C1, W0, W1, PW, RS, A0, A1, A2, A3) do { QKG(g, C0, C1); RS; if constexpr (!RSM && !RSM16) { sacc += A0; sacc += A1; sacc += A2; sacc += A3; PIN(sacc); } W0; W1; PIN(PW); ATT_SBAR(); } while (0)
  #define EX(v) __builtin_amdgcn_exp2f(v)
  #define GAPB(MF, X, B) do { MF; X[B] = EX(X[B]); X[B + 1] = EX(X[B + 1]); X[B + 2] = EX(X[B + 2]); X[B + 3] = EX(X[B + 3]); PIN(X); ATT_SBAR(); } while (0)
  #define VRD(i) do { vlo[i] = vtr(vp_ + (((i) >> 2) * 4096 + ((i) & 3) * 1024)); vhi[i] = vtr(vp_ + (((i) >> 2) * 4096 + ((i) & 3) * 1024 + 512)); } while (0)
  #define KRD(G, j) do { if constexpr ((j) < NDK) { if (G) { kload2(kf, kp0 + sl_next, j); ATT_SBAR(); } } } while (0)
  #define STEP(C0, C1, P0, P1, t, GK, GV, GL) do { ATT_SBAR(); \
    REGION(t); \
    const lds_cptr vp_ = vp0 + sl_prev; \
    float sacc = 0.f; \
    VRD(0); ATT_SBAR(); GAPA(0, C0, C1, (void)0, (void)0, pw0, (void)0, P0[0], P0[1], P0[2], P0[3]); \
    VRD(4); ATT_SBAR(); GAPA(1, C0, C1, (void)0, (void)0, pw0, (void)0, P0[0], P0[1], P0[2], P0[3]); \
    VRD(1); ATT_SBAR(); GAPA(2, C0, C1, (void)0, (void)0, pw0, (void)0, P0[0], P0[1], P0[2], P0[3]); \
    VRD(5); ATT_SBAR(); GAPA(3, C0, C1, (void)0, (void)0, pw0, (void)0, P0[0], P0[1], P0[2], P0[3]); \
    VRD(2); ATT_SBAR(); GAPA(4, C0, C1, pw0[0] = PKW(P0, 0); pw0[1] = PKW(P0, 2); pw0[2] = PKW(P0, 4); pw0[3] = PKW(P0, 6), (void)0, pw0, (void)0, P0[0], P0[1], P0[2], P0[3]); \
    VRD(6); ATT_SBAR(); GAPA(5, C0, C1, pw1[0] = PKW(P0, 8); pw1[1] = PKW(P0, 10); pw1[2] = PKW(P0, 12); pw1[3] = PKW(P0, 14), (void)0, pw1, do { if constexpr (MODEA) ROWSUM(0); } while (0), P0[0], P0[1], P0[2], P0[3]); \
    VRD(3); ATT_SBAR(); GAPA(6, C0, C1, pw2[0] = PKW(P1, 0); pw2[1] = PKW(P1, 2); pw2[2] = PKW(P1, 4); pw2[3] = PKW(P1, 6), (void)0, pw2, do { if constexpr (MODEA) ROWSUM(1); } while (0), P0[0], P0[1], P0[2], P0[3]); \
    VRD(7); ATT_SBAR(); GAPA(7, C0, C1, pw3[0] = PKW(P1, 8); pw3[1] = PKW(P1, 10); pw3[2] = PKW(P1, 12); pw3[3] = PKW(P1, 14), (void)0, pw3, do { if constexpr (MODEA) ROWSUM(2); } while (0), P0[0], P0[1], P0[2], P0[3]); \
    l_reg += sacc; \
    MIDW(t); \
    if (ATT_STAGGER) { if (GV) { DMA_V((t) + 1, sl_next); } if (GK) { DMA_K((t) + 3, sl_cur); } } else { if (GK) { DMA_K((t) + 3, sl_cur); } if (GV) { DMA_V((t) + 1, sl_next); } } \
    BIAS(C0, C1, t); \
    ATT_SBAR(); \
    KRD(GL, 0); do { o[0] = ATT_MFMA(PAF(0), VFR(0), o[0]); if constexpr (MODEA) ROWSUM(3); else ROWSUM(0); C0[0] = EX(C0[0]); C0[1] = EX(C0[1]); C0[2] = EX(C0[2]); C0[3] = EX(C0[3]); PIN(C0); PIN(C1); ATT_SBAR(); } while (0); \
    KRD(GL, 1); do { o[1] = ATT_MFMA(PAF(0), VFR(4), o[1]); if constexpr (!MODEA) ROWSUM(1); C0[4] = EX(C0[4]); C0[5] = EX(C0[5]); C0[6] = EX(C0[6]); C0[7] = EX(C0[7]); PIN(C0); PIN(C1); ATT_SBAR(); } while (0); \
    KRD(GL, 2); do { o[0] = ATT_MFMA(PAF(1), VFR(1), o[0]); if constexpr (!MODEA) ROWSUM(2); C0[8] = EX(C0[8]); C0[9] = EX(C0[9]); C0[10] = EX(C0[10]); C0[11] = EX(C0[11]); PIN(C0); PIN(C1); ATT_SBAR(); } while (0); \
    KRD(GL, 3); do { o[1] = ATT_MFMA(PAF(1), VFR(5), o[1]); if constexpr (!MODEA) ROWSUM(3); C0[12] = EX(C0[12]); C0[13] = EX(C0[13]); C0[14] = EX(C0[14]); C0[15] = EX(C0[15]); PIN(C0); PIN(C1); ATT_SBAR(); } while (0); \
    do { o[0] = ATT_MFMA(PAF(2), VFR(2), o[0]); C1[0] = EX(C1[0]); C1[1] = EX(C1[1]); C1[2] = EX(C1[2]); C1[3] = EX(C1[3]); PIN(C0); PIN(C1); ATT_SBAR(); } while (0); \
    do { o[1] = ATT_MFMA(PAF(2), VFR(6), o[1]); C1[4] = EX(C1[4]); C1[5] = EX(C1[5]); C1[6] = EX(C1[6]); C1[7] = EX(C1[7]); PIN(C0); PIN(C1); ATT_SBAR(); } while (0); \
    do { o[0] = ATT_MFMA(PAF(3), VFR(3), o[0]); C1[8] = EX(C1[8]); C1[9] = EX(C1[9]); C1[10] = EX(C1[10]); C1[11] = EX(C1[11]); PIN(C0); PIN(C1); ATT_SBAR(); } while (0); \
    do { o[1] = ATT_MFMA(PAF(3), VFR(7), o[1]); C1[12] = EX(C1[12]); C1[13] = EX(C1[13]); C1[14] = EX(C1[14]); C1[15] = EX(C1[15]); PIN(C0); PIN(C1); ATT_SBAR(); } while (0); \
    } while (0)
  #define MIDW(tt) do { if (ATT_STAGGER) { if ((tt) + 2 < NT) { ATT_WAIT_BAR(1); } else { ATT_WAIT_BAR(0); } } } while (0)
  #define ENDW(tt) do { if ((tt) + 3 < NT) { ATT_WAIT_BAR(2); } else if ((tt) + 2 < NT) { ATT_WAIT_BAR(1); } else { ATT_WAIT_BAR(0); } } while (0)
  int t = 1;
  for (; t + 5 < NT; t += 2) {
    STEP(pB0, pB1, pA0, pA1, t, true, true, true);       ATT_WAIT_BAR(2); ROT();
    STEP(pA0, pA1, pB0, pB1, t + 1, true, true, true);   ATT_WAIT_BAR(2); ROT();
  }
  for (; t + 1 < NT; t += 2) {
    STEP(pB0, pB1, pA0, pA1, t, (t + 3 < NT), (t + 1 < NT), (t + 1 < NT));       ENDW(t);     ROT();
    STEP(pA0, pA1, pB0, pB1, t + 1, (t + 4 < NT), (t + 2 < NT), (t + 2 < NT));   ENDW(t + 1); ROT();
  }
  STEP(pB0, pB1, pA0, pA1, NT - 1, false, false, false);
  if (nxt) { glds16(ksrc + nxoff, (unsigned)__builtin_amdgcn_readfirstlane(kdst)); glds16(ksrc + nxoff + (long)KVBLK * PITCH, (unsigned)__builtin_amdgcn_readfirstlane(kdst + SLOTB)); glds16(ksrc + nxoff + 2L * KVBLK * PITCH, (unsigned)__builtin_amdgcn_readfirstlane(kdst + 2 * SLOTB)); }
  if (ATT_STAGGER) { ATT_WAIT_BAR(0); if (wid < 4) asm volatile("s_barrier" ::: "memory"); }
  { pw0 = (u32x4){PKW(pB0, 0), PKW(pB0, 2), PKW(pB0, 4), PKW(pB0, 6)}; pw1 = (u32x4){PKW(pB0, 8), PKW(pB0, 10), PKW(pB0, 12), PKW(pB0, 14)};
    pw2 = (u32x4){PKW(pB1, 0), PKW(pB1, 2), PKW(pB1, 4), PKW(pB1, 6)}; pw3 = (u32x4){PKW(pB1, 8), PKW(pB1, 10), PKW(pB1, 12), PKW(pB1, 14)};
    if constexpr (!RSM && !RSM16) { float sacc = 0.f; _Pragma("unroll") for (int r = 0; r < 16; ++r) sacc += pB0[r] + pB1[r]; l_reg += sacc; }
    ATT_SBAR(); ROWSUM(0); ROWSUM(1); ROWSUM(2); ROWSUM(3); pv(o, vb0 + sl_cur, PAF(0), PAF(1), PAF(2), PAF(3)); }
  #undef PKW
  #undef PAF
  #undef VFR
  #undef PIN
  #undef QKG
  #undef ROWSUM
  #undef GAPA
  #undef GAPB
  #undef EX
  #undef VRD
  #undef KRD
  #undef STEP
  #undef ENDW
  #undef MIDW
  #undef CINIT
  bool pre_ok = true;
  float rli[16]; bool bad = false;
  if constexpr (RSM16) {
    if ((lane & 15) < 2) { const int qb_ = 16 * (lane & 15) + 4 * (lane >> 4);
      #pragma unroll
      for (int r = 0; r < 4; ++r) wsf[32 + qb_ + r] = ol4[r]; }
    asm volatile("s_waitcnt lgkmcnt(0)" ::: "memory"); }
  else if constexpr (!RSM) { auto rr = __builtin_amdgcn_permlane32_swap(__float_as_uint(l_reg), __float_as_uint(l_reg), false, false); l_reg = __uint_as_float(rr[0]) + __uint_as_float(rr[1]);
    if (hi == 0) wsf[32 + r32] = l_reg; asm volatile("s_waitcnt lgkmcnt(0)" ::: "memory"); }
  #pragma unroll
  for (int r = 0; r < 16; ++r) { const float l = RSM ? ol[r] : wsf[32 + crow(r, hi)]; bad |= !(l > 1e-30f && l < 1e30f); rli[r] = __builtin_amdgcn_rcpf(l); }
  if (__any(bad)) { if (lane == 0) flag[0] = 1u; }
  if (!MODEA) {
    asm volatile("s_waitcnt lgkmcnt(0)\n\ts_barrier" ::: "memory");
    if (nxt) { glds16(vsrc + nxoff, (unsigned)__builtin_amdgcn_readfirstlane(vdst)); }
    const bool fb = flag[0] != 0u;
    if (!fb) {
      bf16* Ow = AO + (rowbase + qw0) * 1024 + 512 + h * 64;
      __attribute__((address_space(3))) bf16* stg = (__attribute__((address_space(3))) bf16*)(shm3 + LDS_OST) + wid * 4096;
      #pragma unroll
      for (int r = 0; r < 16; ++r) { const int orow = crow(r, hi);
        #pragma unroll
        for (int d0 = 0; d0 < 2; ++d0) stg[orow * 64 + d0 * 32 + r32] = (bf16)(cvtpk_s(o[d0][r] * rli[r], 0.f) & 0xffffu); }
      asm volatile("s_waitcnt lgkmcnt(0)" ::: "memory");
      #pragma unroll
      for (int i = 0; i < 4; ++i) { const int row = i * 8 + (lane >> 3), ch = lane & 7; const u32x4 v = *(const __attribute__((address_space(3))) u32x4*)(stg + row * 64 + ch * 8); *(u32x4*)(Ow + (long)row * 1024 + ch * 8) = v; }
    }
    asm volatile("s_waitcnt lgkmcnt(0)\n\ts_barrier" ::: "memory");
    if (fb) { asm volatile("s_waitcnt vmcnt(0)\n\ts_barrier" ::: "memory"); attn_unit_simple<MODEA>(b, h, qb, QKV, AO, shm, bias_tab, lam, subln); }
    pre_ok = !fb;
  } else {
    lds_fptr stg = (lds_fptr)(shm3 + LDS_OST) + wid * 2048;
    #pragma unroll
    for (int r = 0; r < 16; ++r) { const int orow = crow(r, hi);
      #pragma unroll
      for (int d0 = 0; d0 < 2; ++d0) stg[orow * 64 + d0 * 32 + r32] = o[d0][r] * rli[r]; }
    asm volatile("s_waitcnt lgkmcnt(0)\n\ts_barrier" ::: "memory");
    if (nxt) { glds16(vsrc + nxoff, (unsigned)__builtin_amdgcn_readfirstlane(vdst)); }
    const bool fb = flag[0] != 0u;
    if (!fb) {
      const lds_fptr s1 = (lds_fptr)(shm3 + LDS_OST) + w4 * 2048, s2 = s1 + 4 * 2048;
      bf16* Ow = AO + (rowbase + q0 + 32 * w4) * 1024 + h * 64;
      #pragma unroll
      for (int i = 0; i < 2; ++i) {
        const int row = 16 * part + i * 8 + (lane >> 3), ch = lane & 7;
        const f32x4 a0 = *(const __attribute__((address_space(3))) f32x4*)(s1 + row * 64 + ch * 8), a1 = *(const __attribute__((address_space(3))) f32x4*)(s1 + row * 64 + ch * 8 + 4);
        const f32x4 b0 = *(const __attribute__((address_space(3))) f32x4*)(s2 + row * 64 + ch * 8), b1 = *(const __attribute__((address_space(3))) f32x4*)(s2 + row * 64 + ch * 8 + 4);
        const f32x4 d0v = a0 - b0 * lam, d1v = a1 - b1 * lam;
        float q = ((d0v[0] * d0v[0] + d0v[1] * d0v[1]) + (d0v[2] * d0v[2] + d0v[3] * d0v[3])) + ((d1v[0] * d1v[0] + d1v[1] * d1v[1]) + (d1v[2] * d1v[2] + d1v[3] * d1v[3]));
        q += __shfl_xor(q, 1); q += __shfl_xor(q, 2); q += __shfl_xor(q, 4);
        const float rs = rsqrtf(q * (1.0f / 64.0f) + 1e-6f) * 0.8f;
        const f32x4 g0 = *(const f32x4*)(subln + ch * 8), g1 = *(const f32x4*)(subln + ch * 8 + 4);
        const f32x4 y0 = d0v * rs * g0, y1 = d1v * rs * g1;
        u32x4 w; w.x = cvtpk_s(y0[0], y0[1]); w.y = cvtpk_s(y0[2], y0[3]); w.z = cvtpk_s(y1[0], y1[1]); w.w = cvtpk_s(y1[2], y1[3]);
        *(u32x4*)(Ow + (long)row * 1024 + ch * 8) = w;
      }
    }
    asm volatile("s_waitcnt lgkmcnt(0)\n\ts_barrier" ::: "memory");
    if (fb) { asm volatile("s_waitcnt vmcnt(0)\n\ts_barrier" ::: "memory"); attn_unit_simple<MODEA>(b, h, qb, QKV, AO, shm, bias_tab, lam, subln); }
    pre_ok = !fb;
  }
  #undef DMA_K
  #undef DMA_V
  #undef BIAS
  #undef REGION
  #undef ROT
  return nxt && pre_ok;
}
#undef ATT_WAIT_BAR
#undef ATT_MFMA
#undef ATT_SBAR
}
#define LAS __attribute__((address_space(3)))
#define XB_TMO      128
#define XB_XCNT(j)  (256  + 64 * (j))
#define XB_XSUB(j)  (1280 + 64 * (j))
#define XB_XGEN(j)  (2304 + 64 * (j))
#define XB_TOP      3328
#define XB_TOPGEN   3392
#define XB_LSUB(j)  (3456 + 64 * (j))
#define XB_LGEN(j)  (4480 + 64 * (j))
#define XCD_BAR_WORDS 5504
#define XB_SPIN_CAP (1u << 18)

__device__ __forceinline__ unsigned xb_ld(unsigned* p)              { return __hip_atomic_load(p, __ATOMIC_RELAXED, __HIP_MEMORY_SCOPE_AGENT); }
__device__ __forceinline__ unsigned xb_add(unsigned* p, unsigned v) { return __hip_atomic_fetch_add(p, v, __ATOMIC_RELAXED, __HIP_MEMORY_SCOPE_AGENT); }
__device__ __forceinline__ unsigned xb_xcc_id() { return (unsigned)__builtin_amdgcn_s_getreg((3 << 11) | 20) & 0xFu; }
#define XB_SPIN(cond, bar) do { unsigned _sp = 0; while (cond) { __builtin_amdgcn_s_sleep(1); \
    if ((++_sp & 255u) == 0u) { if (xb_ld(&(bar)[XB_TMO])) break; if (_sp > XB_SPIN_CAP) { atomicAdd(&(bar)[XB_TMO], 1u); break; } } } } while (0)

struct XcdBarrier {
    unsigned* bar; unsigned x;
    volatile LAS unsigned* st;
};

__device__ __forceinline__ XcdBarrier xcd_barrier_post(unsigned* bar, volatile LAS unsigned* st) {
    XcdBarrier b; b.bar = bar; b.x = xb_xcc_id(); b.st = st;
    if (threadIdx.x == 0) st[3] = xb_add(&bar[XB_XCNT(b.x)], 1u);
    return b;
}
__device__ __forceinline__ void xcd_barrier_complete(unsigned* bar, unsigned x, unsigned& nloc, unsigned& nx, unsigned& uni) {
    const unsigned G = gridDim.x * gridDim.y * gridDim.z;
    unsigned sum, cnt, mine, sp = 0u;
    for (;;) {
        sum = 0u; cnt = 0u; mine = 0u; uni = 1u;
#pragma unroll
        for (unsigned j = 0; j < 16; ++j) { const unsigned c = xb_ld(&bar[XB_XCNT(j)]); sum += c; cnt += (c > 0u) ? 1u : 0u; mine = (j == x) ? c : mine; uni = ((c != 0u && c != 32u) || (j >= 8u && c != 0u)) ? 0u : uni; }
        if (sum == G) break;
        __builtin_amdgcn_s_sleep(1);
        if ((++sp & 255u) == 0u) { if (xb_ld(&bar[XB_TMO])) break; if (sp > XB_SPIN_CAP) { atomicAdd(&bar[XB_TMO], 1u); break; } }
    }
    uni = (sum == G && cnt == 8u) ? uni : 0u;
    nloc = mine > 0u ? mine : 1u; nx = cnt > 0u ? cnt : 1u;
}

__device__ __forceinline__ void xcd_barrier(const XcdBarrier& b) {
    asm volatile("s_waitcnt vmcnt(0)" ::: "memory");
    __syncthreads();
    if (threadIdx.x == 0) {
        unsigned* bar = b.bar;
        __builtin_amdgcn_s_waitcnt(0);
        unsigned nloc = b.st[0], nx = b.st[1];
        if (nloc == 0u) { unsigned uni = 0u; xcd_barrier_complete(bar, b.x, nloc, nx, uni); b.st[0] = nloc; b.st[1] = nx; b.st[2] = uni; }
        const unsigned old = xb_add(&bar[XB_XSUB(b.x)], 1u);
        const unsigned gen = old / nloc;
        if (old + 1u == (gen + 1u) * nloc) {
            __builtin_amdgcn_fence(__ATOMIC_RELEASE, "agent");
            asm volatile("s_waitcnt vmcnt(0)" ::: "memory");
            const unsigned og = xb_add(&bar[XB_TOP], 1u);
            const unsigned tg = og / nx;
            if (og + 1u == (tg + 1u) * nx) xb_add(&bar[XB_TOPGEN], 1u);
            else XB_SPIN(xb_ld(&bar[XB_TOPGEN]) == tg, bar);
            __builtin_amdgcn_fence(__ATOMIC_ACQUIRE, "agent");
            xb_add(&bar[XB_XGEN(b.x)], 1u);
            asm volatile("s_waitcnt vmcnt(0)" ::: "memory");
        } else {
            XB_SPIN(xb_ld(&bar[XB_XGEN(b.x)]) == gen, bar);
            __builtin_amdgcn_fence(__ATOMIC_ACQUIRE, "agent");
            asm volatile("s_waitcnt vmcnt(0)" ::: "memory");
        }
    }
    __syncthreads();
}

__device__ __forceinline__ void xcd_barrier_local(const XcdBarrier& b) {
    asm volatile("s_waitcnt vmcnt(0)" ::: "memory");
    __syncthreads();
    if (threadIdx.x == 0) {
        unsigned* bar = b.bar;
        __builtin_amdgcn_s_waitcnt(0);
        const unsigned nloc = b.st[0];
        const unsigned old = xb_add(&bar[XB_LSUB(b.x)], 1u);
        const unsigned gen = old / nloc;
        if (old + 1u == (gen + 1u) * nloc) xb_add(&bar[XB_LGEN(b.x)], 1u);
        else XB_SPIN(xb_ld(&bar[XB_LGEN(b.x)]) == gen, bar);
        __builtin_amdgcn_fence(__ATOMIC_ACQUIRE, "agent");
        asm volatile("s_waitcnt vmcnt(0)" ::: "memory");
    }
    __syncthreads();
}
constexpr int NWAVES = 8;
constexpr int BATCH = 8, SEQ = 4096, D = 1024, FF = 2816, DIN = 2304, M = BATCH * SEQ;
constexpr int NPH = 9;
constexpr size_t MiB = 1u << 20;
constexpr size_t WS_CTL = 0, CTL_ZERO_BYTES = 1 * MiB;
constexpr size_t WS_TAB = 1 * MiB;
constexpr size_t TAB_CS = 256, TAB_BIAS = 256 + 8192;
constexpr int CW_BAR = 4096;
constexpr int CW_SBMAX = CW_BAR + 3456;
constexpr int ZERO_WORDS = 5504;
constexpr size_t TAB_R1 = 32768, TAB_R2 = 32768 + 131072, TAB_SB = 32768 + 2 * 131072;
constexpr size_t WS_AM2 = 6 * MiB;
constexpr size_t WS_SS1 = 2 * MiB, WS_SS2 = 4 * MiB;
constexpr size_t WS_W1GU = 8 * MiB, WS_W1D = 20 * MiB, WS_WIN = 26 * MiB, WS_WOUT = 31 * MiB, WS_W2GU = 34 * MiB, WS_W2D = 46 * MiB;
constexpr size_t WS_A = 56 * MiB;
constexpr size_t WS_B = 232 * MiB;
constexpr size_t WS_C = 296 * MiB;
constexpr size_t WS_D = 360 * MiB;
constexpr size_t WS_END = 424 * MiB;
static_assert(WS_W1GU + (size_t)2 * FF * D * 2 <= WS_W1D && WS_W1D + (size_t)FF * D * 2 <= WS_WIN && WS_WIN + (size_t)DIN * D * 2 <= WS_WOUT && WS_WOUT + (size_t)D * D * 2 <= WS_W2GU &&
              WS_W2GU + (size_t)2 * FF * D * 2 <= WS_W2D && WS_W2D + (size_t)FF * D * 2 <= WS_A && WS_A + (size_t)M * FF * 2 <= WS_B && WS_AM2 + (size_t)M * 64 <= WS_W1GU && TAB_SB + (2 * 5632 + 2304) * 4 <= MiB, "d_ws map");
constexpr int RING_OFF = 0, RING_BYTES = 131072;
constexpr int LDSCTL_OFF = RING_BYTES, MISC_OFF = LDSCTL_OFF + 320;
constexpr int LDS_BYTES = 147456;
static_assert(att::LDS_BYTES <= RING_BYTES, "attention scratch fits the ring region");

#define GAS __attribute__((address_space(1)))
typedef unsigned short bf16;
typedef unsigned v4u __attribute__((ext_vector_type(4)));
typedef float f32x4 __attribute__((ext_vector_type(4)));
#define LDS_WAIT() asm volatile("s_waitcnt lgkmcnt(0)" ::: "memory")
__device__ __forceinline__ unsigned f2bf(float f) { unsigned u = __builtin_bit_cast(unsigned, f); return (u + 0x7fffu + ((u >> 16) & 1u)) >> 16; }
__device__ __forceinline__ unsigned pk2(float lo, float hi) { return pg8::cvt_pk_bf16(lo, hi); }
__device__ __forceinline__ float wave_sum(float v) {
#pragma unroll
    for (int o = 1; o < 64; o <<= 1) v += __shfl_xor(v, o);
    return v;
}

template <bool BLKD>
__device__ __forceinline__ void p0_transpose_item(const float* W, int K, int N, bf16* WT, int k0, int n0, int drow0, const float* g, LAS float* scr, int lane) {
    const int kk8 = lane >> 3, n4 = (lane & 7) * 4;
    f32x4 v[8];
#pragma unroll
    for (int i = 0; i < 8; ++i) v[i] = *(const GAS f32x4*)(W + (size_t)(k0 + i * 8 + kk8) * N + n0 + n4);
#pragma unroll
    for (int i = 0; i < 8; ++i) { const int kk = i * 8 + kk8; const float gg = g ? g[k0 + kk] : 1.0f; LAS float* s = scr + kk * 33 + n4; s[0] = v[i].x * gg; s[1] = v[i].y * gg; s[2] = v[i].z * gg; s[3] = v[i].w * gg; }
    LDS_WAIT(); asm volatile("" ::: "memory");
    const int c = lane & 7;
#pragma unroll
    for (int j = 0; j < 4; ++j) { const int n = (lane >> 3) + 8 * j; const LAS float* s = scr + (8 * c) * 33 + n;
        v4u o; o.x = pk2(s[0 * 33], s[1 * 33]); o.y = pk2(s[2 * 33], s[3 * 33]); o.z = pk2(s[4 * 33], s[5 * 33]); o.w = pk2(s[6 * 33], s[7 * 33]);
        const int dr = drow0 + n;
        if constexpr (BLKD) *(GAS v4u*)(WT + (((size_t)(dr >> 8) * (K / 64) + (k0 >> 6)) * 256 + (dr & 255)) * 64 + 8 * c) = o;
        else *(GAS v4u*)(WT + (size_t)dr * K + k0 + 8 * c) = o; }
    LDS_WAIT(); asm volatile("" ::: "memory");
}

__device__ __forceinline__ float wave_max(float v) {
#pragma unroll
    for (int o = 1; o < 64; o <<= 1) v = fmaxf(v, __shfl_xor(v, o));
    return v;
}
__device__ __forceinline__ unsigned pack4i8(int a, int b, int c, int d) { return ((unsigned)a & 0xffu) | (((unsigned)b & 0xffu) << 8) | (((unsigned)c & 0xffu) << 16) | ((unsigned)d << 24); }
__device__ __forceinline__ unsigned quant4(f32x4 v, float inv) { const f32x4 q = v * inv; return pack4i8((int)__builtin_rintf(q.x), (int)__builtin_rintf(q.y), (int)__builtin_rintf(q.z), (int)__builtin_rintf(q.w)); }
__device__ __forceinline__ void p0_quant_regs(const f32x4 (&v)[8], int K, signed char* W8, int k0, int drow0, const float* g, f32x4 inv, LAS float* scr, int lane) {
    const int kk8 = lane >> 3, n4 = (lane & 7) * 4;
    LAS int* si = (LAS int*)scr;
#pragma unroll
    for (int i = 0; i < 8; ++i) { const int kk = i * 8 + kk8; const float gg = g[k0 + kk]; const f32x4 q = v[i] * gg * inv; LAS int* s = si + kk * 33 + n4;
        s[0] = (int)__builtin_rintf(q.x); s[1] = (int)__builtin_rintf(q.y); s[2] = (int)__builtin_rintf(q.z); s[3] = (int)__builtin_rintf(q.w); }
    LDS_WAIT(); asm volatile("" ::: "memory");
    const int n = lane >> 1, h = lane & 1; const LAS int* s = si + (32 * h) * 33 + n;
    v4u o0, o1;
    o0.x = pack4i8(s[0 * 33], s[1 * 33], s[2 * 33], s[3 * 33]);     o0.y = pack4i8(s[4 * 33], s[5 * 33], s[6 * 33], s[7 * 33]);
    o0.z = pack4i8(s[8 * 33], s[9 * 33], s[10 * 33], s[11 * 33]);   o0.w = pack4i8(s[12 * 33], s[13 * 33], s[14 * 33], s[15 * 33]);
    o1.x = pack4i8(s[16 * 33], s[17 * 33], s[18 * 33], s[19 * 33]); o1.y = pack4i8(s[20 * 33], s[21 * 33], s[22 * 33], s[23 * 33]);
    o1.z = pack4i8(s[24 * 33], s[25 * 33], s[26 * 33], s[27 * 33]); o1.w = pack4i8(s[28 * 33], s[29 * 33], s[30 * 33], s[31 * 33]);
    GAS v4u* dst = (GAS v4u*)(W8 + (size_t)(drow0 + n) * K + k0 + 32 * h);
    dst[0] = o0; dst[1] = o1;
    LDS_WAIT(); asm volatile("" ::: "memory");
}
__device__ __forceinline__ void quant_row_store(signed char* dst, const f32x4 (&v)[4], float inv, int lane) {
    GAS unsigned* d = (GAS unsigned*)dst + lane;
#pragma unroll
    for (int j = 0; j < 4; ++j) d[64 * j] = quant4(v[j], inv);
}

__device__ __forceinline__ void requant_rows(const bf16* Xsrc, const float* ssp, const float* amp, signed char* q8, float* Rr, int gw, int NGW, int lane, int mb = 0, int me = M) {
    constexpr int QR = 8;
    for (int m0 = mb + QR * gw + ((me - mb - 1 - QR * gw) / (QR * NGW)) * (QR * NGW); m0 >= mb; m0 -= QR * NGW) {
        unsigned long long w[QR][4]; float sv[QR], av[QR];
#pragma unroll
        for (int r = 0; r < QR; ++r) { const GAS unsigned long long* xr = (const GAS unsigned long long*)(Xsrc + (size_t)(m0 + r) * D) + lane;
#pragma unroll
            for (int j = 0; j < 4; ++j) w[r][j] = xr[64 * j];
            sv[r] = lane < 16 ? ssp[(size_t)(m0 + r) * 16 + lane] : 0.f; av[r] = lane < 16 ? amp[(size_t)(m0 + r) * 16 + lane] : 0.f; }
#pragma unroll
        for (int r = 0; r < QR; ++r) { const float s = wave_sum(sv[r]), a = wave_max(av[r]);
            f32x4 v[4];
#pragma unroll
            for (int j = 0; j < 4; ++j) v[j] = pg8::bf16lo4((unsigned)w[r][j], (unsigned)(w[r][j] >> 32));
            quant_row_store(q8 + (size_t)(m0 + r) * D, v, a > 0.f ? 127.0f / a : 0.f, lane);
            if (lane == 0) Rr[m0 + r] = a * (1.0f / 127.0f) * rsqrtf(s * (1.f / D) + 1e-6f); }
    }
}

struct Args { const float* in[21]; float* out; unsigned char* ws; int ph_lo, ph_hi; };

__device__ __forceinline__ int t5_bucket(int rel) {
    const int n = rel < 0 ? -rel : rel; int bk;
    if (n < 8) bk = n; else { const int l = 2 + (31 - __clz(n * n)); bk = l < 15 ? l : 15; }
    return bk + (rel > 0 ? 16 : 0);
}

__global__ void __launch_bounds__(NWAVES * 64, 2) mega_fwd(Args args) {
    extern __shared__ __attribute__((aligned(16))) unsigned char lds[];
    LAS unsigned char* ldsp = (LAS unsigned char*)lds;
    volatile LAS unsigned* MISC = (volatile LAS unsigned*)(ldsp + MISC_OFF);
    const int tid = threadIdx.x, lane = tid & 63, wave = __builtin_amdgcn_readfirstlane(tid >> 6);
    const int G = gridDim.x; const int bx = blockIdx.x; const int vcu = (G % 8 == 0) ? (bx % 8) * (G / 8) + bx / 8 : bx;
    unsigned char* ws = args.ws;
    unsigned* ctl = (unsigned*)(ws + WS_CTL);
    const float* x = args.in[0];
    float* out = args.out;
    float* misc = (float*)(ws + WS_TAB); float* cs = misc + TAB_CS / 4; float* bias_tab = misc + TAB_BIAS / 4;
    float* ss1 = (float*)(ws + WS_SS1); float* ss2 = (float*)(ws + WS_SS2); float* ss3 = ss1; float* am2 = (float*)(ws + WS_AM2);
    float* R1 = (float*)(ws + WS_TAB + TAB_R1); float* R2 = (float*)(ws + WS_TAB + TAB_R2); float* sbw = (float*)(ws + WS_TAB + TAB_SB);
    signed char* Win8 = (signed char*)(ws + WS_WIN); signed char* A3q = (signed char*)(ws + WS_END); float* R3 = R1; float* am1 = am2;
    signed char* W1gu8 = (signed char*)(ws + WS_W1GU); signed char* W2gu8 = (signed char*)(ws + WS_W2GU); signed char* A1q = (signed char*)(ws + WS_END); signed char* A2q = (signed char*)(ws + WS_END);
    bf16* W1gu = (bf16*)(ws + WS_W1GU); bf16* W1d = (bf16*)(ws + WS_W1D); bf16* WinT = (bf16*)(ws + WS_WIN); bf16* WoutT = (bf16*)(ws + WS_WOUT); bf16* W2gu = (bf16*)(ws + WS_W2GU); bf16* W2d = (bf16*)(ws + WS_W2D);
    bf16* ACT = (bf16*)(ws + WS_A); bf16* QKV = (bf16*)(ws + WS_A);
    bf16* Xb = (bf16*)(ws + WS_B); bf16* X2b = (bf16*)(ws + WS_B); bf16* X1b = (bf16*)(ws + WS_C); bf16* X3b = (bf16*)(ws + WS_C); bf16* AO = (bf16*)(ws + WS_D);
    for (int u = tid; u < (LDS_BYTES - LDSCTL_OFF) / 4; u += NWAVES * 64) ((LAS unsigned*)(ldsp + LDSCTL_OFF))[u] = 0u;
    __syncthreads();
    XcdBarrier bar = xcd_barrier_post(ctl + CW_BAR, MISC + 8);
    const int lo = args.ph_lo, hi = args.ph_hi;
#define IN(k) (lo <= (k) && (k) < hi)
#define SEAM(k) do { if (IN(k) && IN((k) + 1)) xcd_barrier(bar); } while (0)
    const int gw = vcu * NWAVES + wave, NGW = G * NWAVES;
#ifdef PROBE_TS
    unsigned long long ts_a_ = 0, ts_b_ = 0;
#if PROBE_TS == 100
#define TS_MARK(k) do { if ((k) == 0) ts_a_ = __builtin_amdgcn_s_memrealtime(); if ((k) == 9) ts_b_ = __builtin_amdgcn_s_memrealtime(); } while (0)
#else
#define TS_MARK(k) do { if ((k) == PROBE_TS) ts_a_ = __builtin_amdgcn_s_memrealtime(); if ((k) == PROBE_TS + 1) ts_b_ = __builtin_amdgcn_s_memrealtime(); } while (0)
#endif
#else
#define TS_MARK(k) do { } while (0)
#endif
    TS_MARK(0);

    if (IN(0)) {
        LAS float* scr = (LAS float*)(ldsp + RING_OFF + wave * 16384);
        constexpr int XR = 8;
        for (int m0 = XR * gw; m0 < M; m0 += XR * NGW) {
            f32x4 v[XR][4];
#pragma unroll
            for (int r = 0; r < XR; ++r) { const GAS f32x4* xr = (const GAS f32x4*)(x + (size_t)(m0 + r) * D) + lane;
#pragma unroll
                for (int j = 0; j < 4; ++j) v[r][j] = __builtin_nontemporal_load(xr + 64 * j); }
#pragma unroll
            for (int r = 0; r < XR; ++r) { float s = 0.f, a = 0.f;
#pragma unroll
                for (int j = 0; j < 4; ++j) { s += (v[r][j].x * v[r][j].x + v[r][j].y * v[r][j].y) + (v[r][j].z * v[r][j].z + v[r][j].w * v[r][j].w);
                    a = fmaxf(a, fmaxf(fmaxf(fabsf(v[r][j].x), fabsf(v[r][j].y)), fmaxf(fabsf(v[r][j].z), fabsf(v[r][j].w)))); }
                s = wave_sum(s); a = wave_max(a);
                GAS unsigned long long* o8 = (GAS unsigned long long*)(Xb + (size_t)(m0 + r) * D) + lane;
#pragma unroll
                for (int j = 0; j < 4; ++j) o8[64 * j] = (unsigned long long)pk2(v[r][j].x, v[r][j].y) | ((unsigned long long)pk2(v[r][j].z, v[r][j].w) << 32);
                quant_row_store(A1q + (size_t)(m0 + r) * D, v[r], a > 0.f ? 127.0f / a : 0.f, lane);
                if (lane == 0) R1[m0 + r] = a * (1.0f / 127.0f) * rsqrtf(s * (1.f / D) + 1e-6f); }
        }
        constexpr int I_GU = (D / 64) * (FF / 32), I_DN = (FF / 64) * (D / 32), I_IN = (D / 64) * (DIN / 32), I_OUT = (D / 64) * (D / 32);
        constexpr int NSTRIP_GU = 4 * (FF / 32), NSTRIP = NSTRIP_GU + DIN / 32;
        const int nhw = 2 * G, hw = 2 * vcu + (wave >> 2), w4 = wave & 3;
        LAS float* cm = (LAS float*)(ldsp + RING_OFF + 12288);
        for (int s0 = 0; s0 < NSTRIP; s0 += nhw) {
            const int strip = s0 + hw; const bool valid = strip < NSTRIP;
            const bool isin = valid && strip >= NSTRIP_GU;
            const int which = (valid && !isin) ? strip / (FF / 32) : 0, nb = !valid ? 0 : isin ? strip - NSTRIP_GU : strip % (FF / 32), n0 = 32 * nb;
            const float* W = isin ? args.in[6] : args.in[which == 0 ? 2 : which == 1 ? 3 : which == 2 ? 17 : 18]; const float* gn = isin ? args.in[5] : args.in[which < 2 ? 1 : 16];
            const int NW = isin ? DIN : FF;
            const int drow0 = isin ? 256 * (n0 / 256) + 128 * ((n0 % 64) / 32) + 32 * ((n0 % 256) / 64) : 256 * (n0 / 128) + 128 * (which & 1) + (n0 % 128);
            signed char* W8 = isin ? Win8 : (which < 2 ? W1gu8 : W2gu8); float* sbo = isin ? sbw + 2 * 5632 : sbw + (which >> 1) * 5632;
            const int kk8 = lane >> 3, n4 = (lane & 7) * 4;
            f32x4 v[2][8]; f32x4 mloc = {0.f, 0.f, 0.f, 0.f};
#define P0_LOAD2(q0) do { _Pragma("unroll") for (int q = 0; q < 2; ++q) _Pragma("unroll") for (int i = 0; i < 8; ++i) v[q][i] = *(const GAS f32x4*)(W + (size_t)(64 * (4 * w4 + (q0) + q) + i * 8 + kk8) * NW + n0 + n4); } while (0)
#define P0_MAX2(q0) do { _Pragma("unroll") for (int q = 0; q < 2; ++q) _Pragma("unroll") for (int i = 0; i < 8; ++i) { const float gg = gn[64 * (4 * w4 + (q0) + q) + i * 8 + kk8]; const f32x4 a = __builtin_elementwise_abs(v[q][i] * gg); \
                        mloc.x = fmaxf(mloc.x, a.x); mloc.y = fmaxf(mloc.y, a.y); mloc.z = fmaxf(mloc.z, a.z); mloc.w = fmaxf(mloc.w, a.w); } } while (0)
            if (valid) {
                P0_LOAD2(0); P0_MAX2(0); asm volatile("" ::: "memory"); P0_LOAD2(2); P0_MAX2(2);
#pragma unroll
                for (int o = 8; o < 64; o <<= 1) { mloc.x = fmaxf(mloc.x, __shfl_xor(mloc.x, o)); mloc.y = fmaxf(mloc.y, __shfl_xor(mloc.y, o)); mloc.z = fmaxf(mloc.z, __shfl_xor(mloc.z, o)); mloc.w = fmaxf(mloc.w, __shfl_xor(mloc.w, o)); }
                if (lane < 8) *(LAS f32x4*)(cm + ((wave >> 2) * 4 + w4) * 32 + n4) = mloc;
            }
            __syncthreads();
            if (valid) {
                f32x4 mx = *(const LAS f32x4*)(cm + ((wave >> 2) * 4 + 0) * 32 + n4);
#pragma unroll
                for (int j = 1; j < 4; ++j) { const f32x4 t = *(const LAS f32x4*)(cm + ((wave >> 2) * 4 + j) * 32 + n4); mx.x = fmaxf(mx.x, t.x); mx.y = fmaxf(mx.y, t.y); mx.z = fmaxf(mx.z, t.z); mx.w = fmaxf(mx.w, t.w); }
                f32x4 inv; inv.x = mx.x > 0.f ? 127.0f / mx.x : 0.f; inv.y = mx.y > 0.f ? 127.0f / mx.y : 0.f; inv.z = mx.z > 0.f ? 127.0f / mx.z : 0.f; inv.w = mx.w > 0.f ? 127.0f / mx.w : 0.f;
                if (w4 == 0 && lane < 8) *(f32x4*)(sbo + drow0 + n4) = mx * (1.0f / 127.0f);
                p0_quant_regs(v[0], D, W8, 64 * (4 * w4 + 2), drow0, gn, inv, scr, lane); p0_quant_regs(v[1], D, W8, 64 * (4 * w4 + 3), drow0, gn, inv, scr, lane);
                P0_LOAD2(0);
                p0_quant_regs(v[0], D, W8, 64 * (4 * w4 + 0), drow0, gn, inv, scr, lane); p0_quant_regs(v[1], D, W8, 64 * (4 * w4 + 1), drow0, gn, inv, scr, lane);
            }
            __syncthreads();
#undef P0_LOAD2
#undef P0_MAX2
        }
        constexpr int NITEMS = 2 * I_DN + I_OUT;
        int it_lo, it_hi, it_step;
        if (nhw >= NSTRIP && NSTRIP * 4 + (nhw - NSTRIP) * 4 * 5 >= NITEMS) { if (hw < NSTRIP) { it_lo = hw * 4 + w4; it_hi = it_lo + 1; } else { it_lo = NSTRIP * 4 + ((hw - NSTRIP) * 4 + w4) * 5; it_hi = it_lo + 5; } it_step = 1; if (it_hi > NITEMS) it_hi = NITEMS; }
        else { it_lo = gw; it_hi = NITEMS; it_step = NGW; }
        for (int it = it_lo; it < it_hi; it += it_step) {
            int r = it;
            if (r < 2 * I_DN) { const int which = r / I_DN; r -= which * I_DN; const int nblk = D / 32, kb = r / nblk, nb = r % nblk;
                p0_transpose_item<true>(args.in[which ? 19 : 4], FF, D, which ? W2d : W1d, 64 * kb, 32 * nb, 32 * nb, nullptr, scr, lane); continue; }
            r -= 2 * I_DN;
            { const int nblk = D / 32, kb = r / nblk, nb = r % nblk; p0_transpose_item<false>(args.in[15], D, D, WoutT, 64 * kb, 32 * nb, 32 * nb, nullptr, scr, lane); }
        }
        { const int gt = vcu * NWAVES * 64 + tid;
          if (gt < 1024) { const int pos = gt >> 4, fi = gt & 15; const float inv = powf(10000.0f, -(float)fi / 16.0f); const float ang = (float)pos * inv; cs[2 * gt] = cosf(ang); cs[2 * gt + 1] = sinf(ang); }
          else if (gt < 1024 + 8 * att::TBL_N) { const int i = gt - 1024, h = i / att::TBL_N, rel = i % att::TBL_N - att::TBL_OFF; bias_tab[i] = args.in[14][t5_bucket(rel) * 8 + h] * 1.4426950408889634f; }
          else if (gt == 1024 + 8 * att::TBL_N) { float s1 = 0.f, s2 = 0.f; for (int d = 0; d < 32; ++d) { s1 += args.in[7][d] * args.in[8][d]; s2 += args.in[9][d] * args.in[10][d]; } misc[0] = expf(s1) - expf(s2) + 0.2f; } }
    }
    SEAM(0); TS_MARK(1);
    const bool loc = (G == 256) && (__builtin_amdgcn_readfirstlane((int)MISC[10]) != 0);
    const int xid = (int)bar.x, rank = __builtin_amdgcn_readfirstlane((int)MISC[11]);
    const int vc = loc ? xid * 32 + rank : vcu, vb = loc ? rank * 8 + xid : bx;
    const int gwl = loc ? rank * NWAVES + wave : gw, ngwl = loc ? 32 * NWAVES : NGW, mbl = loc ? 4096 * xid : 0, mel = loc ? 4096 * xid + 4096 : M;
#define SEAML(k) do { if (IN(k) && IN((k) + 1)) { if (loc) xcd_barrier_local(bar); else xcd_barrier(bar); } } while (0)
#define BARL() do { if (loc) xcd_barrier_local(bar); else xcd_barrier(bar); } while (0)
    if (IN(1)) { pg8::Gemm g{(const bf16*)A1q, (const bf16*)W1gu8, M, 2 * FF, D / 2}; pg8::StaticOrder S; S.init(M, 2 * FF, G, vb); pg8::EpiSwiGLU8<true> E{ACT, FF, R1, sbw};
        pg8::gemm_phase<pg8::EpiSwiGLU8<true>, pg8::StaticOrder, true, true>(ldsp + RING_OFF, g, S, E); }
    SEAML(1); TS_MARK(2);
    if (IN(2)) { pg8::Gemm g{ACT, W1d, M, D, FF}; pg8::StaticOrder S; S.init(M, D, G, vb); pg8::EpiResid<true> E{Xb, X1b, ss1, 0.5f, am1};
        pg8::gemm_phase<pg8::EpiResid<true>, pg8::StaticOrder, true, true, true>(ldsp + RING_OFF, g, S, E); }
    SEAML(2); TS_MARK(3);
    if (IN(3)) {
        requant_rows(X1b, ss1, am1, A3q, R3, gwl, ngwl, lane, mbl, mel);
        BARL();
        pg8::Gemm g{(const bf16*)A3q, (const bf16*)Win8, M, DIN, D / 2}; pg8::StaticOrder S; S.init(M, DIN, G, vb); pg8::EpiProjT<true> E{QKV, R3, args.in[12], args.in[13], cs, sbw + 2 * 5632};
        pg8::gemm_phase<pg8::EpiProjT<true>, pg8::StaticOrder, true, true>(ldsp + RING_OFF, g, S, E); }
    SEAML(3); TS_MARK(4);
#ifdef PROBE_IDLE
    { const unsigned long long t0_ = __builtin_amdgcn_s_memrealtime(); while (__builtin_amdgcn_s_memrealtime() - t0_ < (unsigned long long)(PROBE_IDLE)) __builtin_amdgcn_s_sleep(16); }
#endif
    if (IN(4)) {
        const float lam = misc[0];
        { const int NU = BATCH * 8 * 32, upc = (NU + G - 1) / G;
          bool pre = false;
          if (loc) {
              for (int i = 0; i < 8; ++i) pre = att::attn_unit<true>(xid, i, rank, QKV, AO, (char*)lds + RING_OFF, bias_tab, lam, args.in[11], pre, i + 1 < 8, 64);
          } else
          for (int i = 0; i < upc; ++i) { const int u = vc * upc + i; if (u >= NU) break; const int bh = u >> 5, qb = u & 31;
              const bool nxt = (i + 1 < upc) && (u + 1 < NU) && (((u + 1) >> 5) == bh);
              pre = att::attn_unit<true>(bh >> 3, bh & 7, qb, QKV, AO, (char*)lds + RING_OFF, bias_tab, lam, args.in[11], pre, nxt); } }
        { const int NU = BATCH * 8 * 16, upc = (NU + G - 1) / G;
          bool pre = false;
          if (loc) {
              for (int i = 0; i < 4; ++i) { const int w = rank * 2 + (i & 1), h = (i >> 1) * 4 + (w >> 4), qb = w & 15;
                  pre = att::attn_unit<false>(xid, h, qb, QKV, AO, (char*)lds + RING_OFF, bias_tab, lam, args.in[11], pre, i + 1 < 4, i == 1 ? 64 : 0); }
          } else
          for (int i = 0; i < upc; ++i) { const int u = vc * upc + i; if (u >= NU) break; const int bh = u >> 4, qb = u & 15;
              const bool nxt = (i + 1 < upc) && (u + 1 < NU) && (((u + 1) >> 4) == bh);
              pre = att::attn_unit<false>(bh >> 3, bh & 7, qb, QKV, AO, (char*)lds + RING_OFF, bias_tab, lam, args.in[11], pre, nxt); } }
    }
#ifdef PROBE_XBAR
    if (IN(4)) for (int i_ = 0; i_ < PROBE_XBAR; ++i_) xcd_barrier(bar);
#endif
    SEAML(4); TS_MARK(5);
    if (IN(5)) { pg8::Gemm g{AO, WoutT, M, D, D}; pg8::StaticOrder S; S.init(M, D, G, vb); pg8::EpiResid<true> E{X1b, X2b, ss2, 1.0f, am2};
        pg8::gemm_phase<pg8::EpiResid<true>, pg8::StaticOrder, true, true>(ldsp + RING_OFF, g, S, E); }
    SEAML(5); TS_MARK(6);
    if (IN(6)) {
        requant_rows(X2b, ss2, am2, A2q, R2, gwl, ngwl, lane, mbl, mel);
        BARL();
        pg8::Gemm g{(const bf16*)A2q, (const bf16*)W2gu8, M, 2 * FF, D / 2}; pg8::StaticOrder S; S.init(M, 2 * FF, G, vb); pg8::EpiSwiGLU8<true> E{ACT, FF, R2, sbw + 5632};
        pg8::gemm_phase<pg8::EpiSwiGLU8<true>, pg8::StaticOrder, true, true>(ldsp + RING_OFF, g, S, E); }
    SEAML(6); TS_MARK(7);
    if (IN(7)) { pg8::Gemm g{ACT, W2d, M, D, FF}; pg8::StaticOrder S; S.init(M, D, G, vb); pg8::EpiResid<false> E{X2b, X3b, ss3, 0.5f, nullptr};
        pg8::gemm_phase<pg8::EpiResid<false>, pg8::StaticOrder, true, true, true>(ldsp + RING_OFF, g, S, E); }
    SEAML(7); TS_MARK(8);
    if (IN(8)) {
        const f32x4* gr = (const f32x4*)args.in[20] + lane;
        f32x4 gg[4];
#pragma unroll
        for (int j = 0; j < 4; ++j) gg[j] = gr[64 * j];
        constexpr int FR = 8;
        for (int m0 = mbl + FR * gwl + ((mel - mbl - 1 - FR * gwl) / (FR * ngwl)) * (FR * ngwl); m0 >= mbl; m0 -= FR * ngwl) {
            unsigned long long w[FR][4]; float rstd[FR];
#pragma unroll
            for (int r = 0; r < FR; ++r) { const GAS unsigned long long* xr = (const GAS unsigned long long*)(X3b + (size_t)(m0 + r) * D) + lane;
#pragma unroll
                for (int j = 0; j < 4; ++j) w[r][j] = xr[64 * j];
                rstd[r] = lane < 16 ? ss3[(size_t)(m0 + r) * 16 + lane] : 0.f; }
#pragma unroll
            for (int r = 0; r < FR; ++r) { rstd[r] = rsqrtf(wave_sum(rstd[r]) * (1.f / D) + 1e-6f); GAS f32x4* orow = (GAS f32x4*)(out + (size_t)(m0 + r) * D) + lane;
#pragma unroll
                for (int j = 0; j < 4; ++j) { const f32x4 v = pg8::bf16lo4((unsigned)w[r][j], (unsigned)(w[r][j] >> 32)); __builtin_nontemporal_store(v * rstd[r] * gg[j], orow + 64 * j); } }
        }
    }
#if defined(PROBE_TS) && (PROBE_TS == 8 || PROBE_TS == 100)
    xcd_barrier(bar);
#endif
    TS_MARK(9);
#ifdef PROBE_TS
    if (bx == 0 && wave == 0) { const unsigned long long d_ = ts_b_ - ts_a_, t0_ = __builtin_amdgcn_s_memrealtime(); while (__builtin_amdgcn_s_memrealtime() - t0_ < d_) __builtin_amdgcn_s_sleep(8); }
#endif
#undef IN
#undef SEAM
}

extern "C" void kernel_launch(void* const* d_in, const int* in_sizes, int n_in, void* d_out, int out_size, void* d_ws, size_t ws_size, hipStream_t stream) {
    static int grid = 0;
    if (grid == 0) {
        if (n_in != 21 || in_sizes[0] != M * D || out_size != M * D || ws_size < WS_END + 32 * MiB) { fprintf(stderr, "kernel_launch: unexpected shapes (n_in %d, in0 %d, out %d, ws %zu)\n", n_in, n_in > 0 ? in_sizes[0] : -1, out_size, ws_size); grid = -1; return; }
        int dev = 0, cus = 0, per_cu = 0;
        if (hipGetDevice(&dev) != hipSuccess || hipDeviceGetAttribute(&cus, hipDeviceAttributeMultiprocessorCount, dev) != hipSuccess) { grid = -1; return; }
        if (hipFuncSetAttribute((const void*)mega_fwd, hipFuncAttributeMaxDynamicSharedMemorySize, LDS_BYTES) != hipSuccess) { fprintf(stderr, "kernel_launch: hipFuncSetAttribute failed\n"); grid = -1; return; }
        if (hipOccupancyMaxActiveBlocksPerMultiprocessor(&per_cu, (const void*)mega_fwd, NWAVES * 64, LDS_BYTES) != hipSuccess || per_cu < 1) { fprintf(stderr, "kernel_launch: occupancy query reports %d workgroups per CU\n", per_cu); (void)hipGetLastError(); grid = -1; return; }
        grid = cus;
    }
    if (grid < 0) return;
    if (hipMemsetAsync((char*)d_ws + WS_CTL + CW_BAR * 4, 0, ZERO_WORDS * 4, stream) != hipSuccess) return;
    Args a{};
    for (int i = 0; i < 21; ++i) a.in[i] = (const float*)d_in[i];
    a.out = (float*)d_out; a.ws = (unsigned char*)d_ws; a.ph_lo = 0; a.ph_hi = NPH;
#ifdef PROBE_SPLIT
    a.ph_hi = PROBE_SPLIT + 1;
    hipLaunchKernelGGL(mega_fwd, dim3(grid), dim3(NWAVES * 64), LDS_BYTES, stream, a);
    if (hipMemsetAsync((char*)d_ws + WS_CTL, 0, CTL_ZERO_BYTES, stream) != hipSuccess) return;
    a.ph_lo = PROBE_SPLIT; a.ph_hi = NPH;
#endif
    hipLaunchKernelGGL(mega_fwd, dim3(grid), dim3(NWAVES * 64), LDS_BYTES, stream, a);
}
```
